# Optimizing an MI355X kernel written in HIP

```python
import math
import jax, jax.numpy as jnp
from jax import lax
import numpy as np

D_MODEL = 2048
BATCH = 2
SEQ = 8192
DEPTH = 2
DEC_BATCH = 8
DEC_SEQ = 4096
PAST_LEN = 128

N_META = 16
MIX_WIDTH = D_MODEL
F_GROUPS = 4
F_GROUP_DIM = 128
F_WIDTH = F_GROUPS * F_GROUP_DIM
MLA_HEADS = 8
Q_LORA = 768
KV_LORA = 512
QK_NOPE = 128
QK_ROPE = 64
V_HEAD = 128
MLA_WIDTH = MLA_HEADS * V_HEAD
ROPE_THETA = 10000.0
DIFF_HEADS = 4
DIFF_QK = 64
DIFF_V = 2 * DIFF_QK
DIFF_WIDTH = DIFF_HEADS * DIFF_V
REL_BUCKETS = 32
REL_MAX_DIST = 128
Q_BLOCK = 128
NORM_EPS = 1e-6

IN_SIZES = [F_WIDTH, Q_LORA, KV_LORA, QK_ROPE,
            DIFF_HEADS * 2 * DIFF_QK, DIFF_HEADS * 2 * DIFF_QK, DIFF_WIDTH, MIX_WIDTH]
IN_WIDTH = sum(IN_SIZES)
IN_SPLITS = [int(v) for v in np.cumsum(IN_SIZES[:-1])]

kernel_name = 'hybrid_fnet_mla_diffattn_encoder'


def rmsnorm(x, g, eps=NORM_EPS):
    xf = x.astype(jnp.float32)
    y = xf * lax.rsqrt(jnp.mean(xf * xf, axis=-1, keepdims=True) + eps)
    return (y * g.astype(jnp.float32)).astype(x.dtype)


def rope_tables(seq_len):
    pos = jnp.arange(seq_len, dtype=jnp.float32)
    inv_freq = ROPE_THETA ** (-jnp.arange(0, QK_ROPE, 2, dtype=jnp.float32) / QK_ROPE)
    ang = pos[:, None] * inv_freq[None, :]
    return jnp.cos(ang), jnp.sin(ang)


def apply_rope(x, cos, sin):
    xf = x.astype(jnp.float32)
    x1, x2 = xf[..., :QK_ROPE // 2], xf[..., QK_ROPE // 2:]
    return jnp.concatenate([x1 * cos - x2 * sin, x2 * cos + x1 * sin], axis=-1).astype(x.dtype)


def t5_bucket(rel):
    nb = REL_BUCKETS // 2
    max_exact = nb // 2
    ret = (rel > 0).astype(jnp.int32) * nb
    n = jnp.abs(rel)
    nf = jnp.maximum(n, 1).astype(jnp.float32)
    large = max_exact + (jnp.log(nf / max_exact) / math.log(REL_MAX_DIST / max_exact)
                         * (nb - max_exact)).astype(jnp.int32)
    large = jnp.minimum(large, nb - 1)
    return ret + jnp.where(n < max_exact, n, large)


def sweep_queries(attend, qs, seq_len):
    pos = jnp.arange(seq_len, dtype=jnp.int32)
    head = attend(tuple(q[:, :N_META] for q in qs), pos[:N_META])
    n_blk = (seq_len - N_META) // Q_BLOCK

    def to_blocks(q):
        r = q[:, N_META:]
        r = r.reshape((r.shape[0], n_blk, Q_BLOCK) + r.shape[2:])
        return jnp.moveaxis(r, 1, 0)

    blks = tuple(to_blocks(q) for q in qs)
    pos_b = pos[N_META:].reshape(n_blk, Q_BLOCK)
    out = lax.map(lambda a: attend(a[0], a[1]), (blks, pos_b))
    out = jnp.moveaxis(out, 0, 1)
    out = out.reshape((out.shape[0], n_blk * Q_BLOCK) + out.shape[3:])
    return jnp.concatenate([head, out], axis=1)


def mixer_layer(x, l, rel_bias, norm_w, w_in, w_fmix, q_norm, w_uq, kv_norm, w_ukv,
                lam_q1, lam_k1, lam_q2, lam_k2, diff_norm, w_o):
    B, S, _ = x.shape
    dt = x.dtype
    h = rmsnorm(x, norm_w[l])
    proj = jnp.einsum('bsd,de->bse', h, w_in[l])
    u_f, c_q, c_kv, k_r, q_d, k_d, v_d, gate = jnp.split(proj, IN_SPLITS, axis=-1)

    uf = u_f.reshape(B, S, F_GROUPS, F_GROUP_DIM).astype(jnp.float32)
    f = jnp.fft.fft2(uf, axes=(1, 3), norm='ortho').real.astype(dt)
    y_f = jnp.einsum('bsgc,gcd->bsgd', f, w_fmix[l]).reshape(B, S, F_WIDTH)

    cos, sin = rope_tables(S)
    cq = rmsnorm(c_q, q_norm[l])
    q = jnp.einsum('bsr,re->bse', cq, w_uq[l]).reshape(B, S, MLA_HEADS, QK_NOPE + QK_ROPE)
    q_nope = q[..., :QK_NOPE]
    q_rope = apply_rope(q[..., QK_NOPE:], cos[:, None, :], sin[:, None, :])
    ckv = rmsnorm(c_kv, kv_norm[l])
    kv = jnp.einsum('bsr,re->bse', ckv, w_ukv[l]).reshape(B, S, MLA_HEADS, QK_NOPE + V_HEAD)
    k_nope = kv[..., :QK_NOPE]
    v_mla = kv[..., QK_NOPE:]
    k_rope = apply_rope(k_r, cos, sin)
    mla_scale = 1.0 / math.sqrt(QK_NOPE + QK_ROPE)

    def attend_mla(qb, pb):
        qn, qr = qb
        s = (jnp.einsum('bthd,bshd->bhts', qn, k_nope)
             + jnp.einsum('bthd,bsd->bhts', qr, k_rope)).astype(jnp.float32) * mla_scale
        p = jax.nn.softmax(s, axis=-1)
        return jnp.einsum('bhts,bshd->bthd', p.astype(dt), v_mla)

    y_mla = sweep_queries(attend_mla, (q_nope, q_rope), S).reshape(B, S, MLA_WIDTH)

    qd = q_d.reshape(B, S, DIFF_HEADS, 2, DIFF_QK)
    kd = k_d.reshape(B, S, DIFF_HEADS, 2, DIFF_QK)
    q1, q2 = qd[..., 0, :], qd[..., 1, :]
    k1, k2 = kd[..., 0, :], kd[..., 1, :]
    vd = v_d.reshape(B, S, DIFF_HEADS, DIFF_V)
    lam_init = 0.8 - 0.6 * math.exp(-0.3 * l)
    lam = (jnp.exp(jnp.sum(lam_q1[l].astype(jnp.float32) * lam_k1[l].astype(jnp.float32)))
           - jnp.exp(jnp.sum(lam_q2[l].astype(jnp.float32) * lam_k2[l].astype(jnp.float32)))
           + lam_init)
    diff_scale = 1.0 / math.sqrt(DIFF_QK)
    kpos = jnp.arange(S, dtype=jnp.int32)
    table = rel_bias.astype(jnp.float32)

    def attend_diff(qb, pb):
        qa, qb2 = qb
        bucket = t5_bucket(kpos[None, :] - pb[:, None])
        bias = jnp.transpose(table[bucket], (2, 0, 1))[None]
        s1 = jnp.einsum('bthd,bshd->bhts', qa, k1).astype(jnp.float32) * diff_scale + bias
        s2 = jnp.einsum('bthd,bshd->bhts', qb2, k2).astype(jnp.float32) * diff_scale + bias
        a = jax.nn.softmax(s1, axis=-1) - lam * jax.nn.softmax(s2, axis=-1)
        return jnp.einsum('bhts,bshd->bthd', a.astype(dt), vd)

    o_d = sweep_queries(attend_diff, (q1, q2), S)
    o_d = rmsnorm(o_d, diff_norm[l], eps=1e-5) * jnp.asarray(1.0 - lam_init, dt)
    y_d = o_d.reshape(B, S, DIFF_WIDTH)

    y = jnp.concatenate([y_f, y_mla, y_d], axis=-1) * jax.nn.silu(gate)
    return x + jnp.einsum('bse,ed->bsd', y, w_o[l])


def encode(x, meta_tokens, rel_bias, final_norm, norm_w, w_in, w_fmix, q_norm, w_uq,
           kv_norm, w_ukv, lam_q1, lam_k1, lam_q2, lam_k2, diff_norm, w_o):
    B = x.shape[0]
    meta = jnp.broadcast_to(meta_tokens.astype(x.dtype)[None], (B, N_META, D_MODEL))
    h = jnp.concatenate([meta, x], axis=1)
    for l in range(DEPTH):
        h = mixer_layer(h, l, rel_bias, norm_w, w_in, w_fmix, q_norm, w_uq, kv_norm, w_ukv,
                        lam_q1, lam_k1, lam_q2, lam_k2, diff_norm, w_o)
    h = rmsnorm(h, final_norm)
    return h[:, N_META:]


def setup_inputs(seed: int = 0) -> dict:
    key = jax.random.key(seed)
    ks = jax.random.split(key, 20)
    nrm = jax.random.normal
    f32 = jnp.float32
    return {
        'x_prompt': nrm(ks[0], (BATCH, SEQ, D_MODEL), f32),
        'x_sample': nrm(ks[1], (DEC_BATCH, DEC_SEQ, D_MODEL), f32),
        'meta_tokens': nrm(ks[2], (N_META, D_MODEL), f32),
        'rel_bias': 0.1 * nrm(ks[3], (REL_BUCKETS, DIFF_HEADS), f32),
        'final_norm': 1.0 + 0.01 * nrm(ks[4], (D_MODEL,), f32),
        'norm_w': 1.0 + 0.01 * nrm(ks[5], (DEPTH, D_MODEL), f32),
        'w_in': nrm(ks[6], (DEPTH, D_MODEL, IN_WIDTH), f32) * D_MODEL ** -0.5,
        'w_fmix': nrm(ks[7], (DEPTH, F_GROUPS, F_GROUP_DIM, F_GROUP_DIM), f32) * F_GROUP_DIM ** -0.5,
        'q_norm': 1.0 + 0.01 * nrm(ks[8], (DEPTH, Q_LORA), f32),
        'w_uq': nrm(ks[9], (DEPTH, Q_LORA, MLA_HEADS * (QK_NOPE + QK_ROPE)), f32) * Q_LORA ** -0.5,
        'kv_norm': 1.0 + 0.01 * nrm(ks[10], (DEPTH, KV_LORA), f32),
        'w_ukv': nrm(ks[11], (DEPTH, KV_LORA, MLA_HEADS * (QK_NOPE + V_HEAD)), f32) * KV_LORA ** -0.5,
        'lam_q1': 0.1 * nrm(ks[12], (DEPTH, DIFF_QK), f32),
        'lam_k1': 0.1 * nrm(ks[13], (DEPTH, DIFF_QK), f32),
        'lam_q2': 0.1 * nrm(ks[14], (DEPTH, DIFF_QK), f32),
        'lam_k2': 0.1 * nrm(ks[15], (DEPTH, DIFF_QK), f32),
        'diff_norm': 1.0 + 0.01 * nrm(ks[16], (DEPTH, DIFF_V), f32),
        'w_o': nrm(ks[17], (DEPTH, MIX_WIDTH, D_MODEL), f32) * MIX_WIDTH ** -0.5,
    }


def reference(x_prompt, x_sample, meta_tokens, rel_bias, final_norm, norm_w, w_in, w_fmix,
              q_norm, w_uq, kv_norm, w_ukv, lam_q1, lam_k1, lam_q2, lam_k2, diff_norm, w_o):
    y_prompt = encode(x_prompt, meta_tokens, rel_bias, final_norm, norm_w, w_in, w_fmix,
                      q_norm, w_uq, kv_norm, w_ukv, lam_q1, lam_k1, lam_q2, lam_k2, diff_norm, w_o)
    y_sample = encode(x_sample, meta_tokens, rel_bias, final_norm, norm_w, w_in, w_fmix,
                      q_norm, w_uq, kv_norm, w_ukv, lam_q1, lam_k1, lam_q2, lam_k2, diff_norm, w_o)
    return (y_prompt, y_sample)
```

```cpp
#include <hip/hip_runtime.h>
#include <hip/hip_cooperative_groups.h>
#include <cstdio>
#include <cstring>
#include <cmath>
namespace cg = cooperative_groups;

#ifndef COOP
#define COOP 1
#endif

typedef unsigned short u16;
using bf16x8 = __attribute__((ext_vector_type(8))) short;
using f32x16 = __attribute__((ext_vector_type(16))) float;
using u32x4 = __attribute__((ext_vector_type(4))) unsigned;
using u32x2 = __attribute__((ext_vector_type(2))) unsigned;
#define DI __device__ __forceinline__
#define MFMA(a, b, c) __builtin_amdgcn_mfma_f32_32x32x16_bf16((a), (b), (c), 0, 0, 0)

constexpr int DM = 2048;
constexpr int INW = 5440;
constexpr int INWP = 5504;
constexpr float LOG2E = 1.4426950408889634f;
constexpr int NTHR = 256;
constexpr int SMEM_BYTES = 256 * 144 + 128 * 144 + 1024;

struct GroupP {
  const float* x;
  float* out;
  int B, L, Lp, T;
  int seq0, Hp;
  u16 *xb, *uf, *cq, *ckv, *kr, *qd, *kd, *vdt, *g, *q, *abt, *fm;
  u16* h1b;
};
struct Params {
  GroupP grp[2];
  const float *meta, *rel_bias, *final_norm, *norm_w, *w_in, *w_fmix, *q_norm, *w_uq, *kv_norm, *w_ukv;
  const float *lq1, *lk1, *lq2, *lk2, *diff_norm, *w_o;
  u16 *winT, *wuqT, *wukvT, *woT, *mfT;
  float2* rope;
  float* lam;
  float* hmeta;
  int* ctr;
  unsigned* bar;
  float* rowsq;
  float rope_hi[32], rope_lo[32];
};

DI unsigned pk2(float lo, float hi) {
  typedef __bf16 bf2 __attribute__((ext_vector_type(2)));
  typedef float f2 __attribute__((ext_vector_type(2)));
  f2 v = {lo, hi};
  return __builtin_bit_cast(unsigned, __builtin_convertvector(v, bf2));
}
DI u16 bf1(float x) { return (u16)(pk2(x, 0.f) & 0xffffu); }
DI float bf_lo(unsigned u) { return __uint_as_float(u << 16); }
DI float bf_hi(unsigned u) { return __uint_as_float(u & 0xffff0000u); }
DI int tid_() { int t = threadIdx.x; asm volatile("" : "+v"(t)); return t; }
DI int crow(int i, int h) { return (i & 3) + 8 * (i >> 2) + 4 * h; }
DI float wave_sum(float v) {
#pragma unroll
  for (int o = 32; o >= 1; o >>= 1) v += __shfl_xor(v, o, 64);
  return v;
}

struct ASrc { const u16* p; long ld; };

DI float dot2bf(unsigned a, float c) {
  typedef __bf16 bf2 __attribute__((ext_vector_type(2)));
  bf2 x = __builtin_bit_cast(bf2, a);
  return __builtin_amdgcn_fdot2_f32_bf16(x, x, c, false);
}

template <bool SWAP, bool SSQ, class AF>
DI void gemm_main(AF asrc, int m0, const u16* __restrict__ Bw, int ldb, int K, char* smem,
                  f32x16 (&acc)[4][2], float ssq_eps, float (&rs)[4]) {
  const int tid = tid_(), lane = tid & 63, wid = __builtin_amdgcn_readfirstlane(tid >> 6);
  const int wm = wid >> 1, wn = wid & 1, lr = lane & 31, lh = lane >> 5;
  char* sA = smem;
  char* sB = smem + 256 * 144;
  const int srow = tid >> 3, skc = tid & 7;
  const unsigned lds_st = srow * 144 + skc * 16;
  const unsigned voffB = (unsigned)(srow * ldb * 2 + skc * 16);
  u32x4 ra[8], rb[4];
#pragma unroll
  for (int i = 0; i < 4; ++i) rs[i] = 0.f;
#pragma unroll
  for (int mi = 0; mi < 4; ++mi)
#pragma unroll
    for (int ni = 0; ni < 2; ++ni)
#pragma unroll
      for (int i = 0; i < 16; ++i) acc[mi][ni][i] = 0.f;

  auto gload = [&](int kt) {
    ASrc s = asrc(kt);
    const unsigned voffA = (unsigned)(srow * (int)s.ld * 2 + skc * 16);
    const char* ua = (const char*)s.p + (long)m0 * s.ld * 2;
#pragma unroll
    for (int i = 0; i < 8; ++i) ra[i] = *(const u32x4*)(ua + (long)(32 * i) * s.ld * 2 + voffA);
    const char* ub = (const char*)Bw + (long)kt * 128;
#pragma unroll
    for (int i = 0; i < 4; ++i) rb[i] = *(const u32x4*)(ub + (long)(32 * i) * ldb * 2 + voffB);
  };
  auto sstore = [&]() {
#pragma unroll
    for (int i = 0; i < 8; ++i) *(u32x4*)(sA + lds_st + i * (32 * 144)) = ra[i];
#pragma unroll
    for (int i = 0; i < 4; ++i) *(u32x4*)(sB + lds_st + i * (32 * 144)) = rb[i];
  };

  const int nkt = K >> 6;
  const char* pA = sA + (wm * 128 + lr) * 144 + lh * 16;
  const char* pB = sB + (wn * 64 + lr) * 144 + lh * 16;
  gload(0);
  sstore();
  __syncthreads();
  for (int kt = 0; kt < nkt; ++kt) {
    if (kt + 1 < nkt) gload(kt + 1);
    __builtin_amdgcn_sched_barrier(0);
    {
      bf16x8 ar[3], br[2][2];
      ar[0] = *(const bf16x8*)(pA);
      ar[1] = *(const bf16x8*)(pA + 32 * 144);
      br[0][0] = *(const bf16x8*)(pB);
      br[0][1] = *(const bf16x8*)(pB + 32 * 144);
      __builtin_amdgcn_sched_group_barrier(0x100, 4, 0);
#pragma unroll
      for (int t = 0; t < 16; ++t) {
        const int ks = t >> 2, mi = t & 3;
        if (t + 2 < 16) {
          ar[(t + 2) % 3] = *(const bf16x8*)(pA + ((t + 2) & 3) * (32 * 144) + ((t + 2) >> 2) * 32);
          if (mi == 1 && ks + 1 < 4) {
            br[(ks + 1) & 1][0] = *(const bf16x8*)(pB + (ks + 1) * 32);
            br[(ks + 1) & 1][1] = *(const bf16x8*)(pB + 32 * 144 + (ks + 1) * 32);
            __builtin_amdgcn_sched_group_barrier(0x100, 3, 0);
          } else {
            __builtin_amdgcn_sched_group_barrier(0x100, 1, 0);
          }
        }
        acc[mi][0] = SWAP ? MFMA(br[ks & 1][0], ar[t % 3], acc[mi][0]) : MFMA(ar[t % 3], br[ks & 1][0], acc[mi][0]);
        acc[mi][1] = SWAP ? MFMA(br[ks & 1][1], ar[t % 3], acc[mi][1]) : MFMA(ar[t % 3], br[ks & 1][1], acc[mi][1]);
        __builtin_amdgcn_sched_group_barrier(0x008, 2, 0);
        if (SSQ) {
          u32x4 u = __builtin_bit_cast(u32x4, ar[t % 3]);
#pragma unroll
          for (int j = 0; j < 4; ++j) rs[mi] = dot2bf(u[j], rs[mi]);
        }
      }
    }
    __syncthreads();
    if (kt + 1 < nkt) sstore();
    __syncthreads();
  }
  if (SSQ) {
#pragma unroll
    for (int mi = 0; mi < 4; ++mi) {
      float v = rs[mi] + __shfl_xor(rs[mi], 32, 64);
      rs[mi] = __builtin_amdgcn_rsqf(v / (float)K + ssq_eps);
    }
  }
}

DI int xcd_tile(int it, int total) {
  const int per = (total + 7) >> 3;
  const int j = it >> 3;
  const int t = (it & 7) * per + j;
  return (j < per && t < total) ? t : -1;
}
constexpr int TGM = 4;
DI void tile_mn(int t, int nmt, int nnt, int& mt, int& nt) {
  const int gs = TGM * nnt;
  const int mg = t / gs, r = t - mg * gs;
  const int rem = nmt - mg * TGM;
  const int gsz = rem < TGM ? rem : TGM;
  nt = r / gsz;
  mt = mg * TGM + (r - nt * gsz);
}

DI float silu(float x) { return x * __builtin_amdgcn_rcpf(1.f + __builtin_amdgcn_exp2f(-x * LOG2E)); }

DI void store_bf4(u16* dst, float a, float b, float c, float d) {
  u32x2 v;
  v[0] = pk2(a, b);
  v[1] = pk2(c, d);
  *(u32x2*)dst = v;
}

DI void wprep_item(const float* __restrict__ src, u16* __restrict__ dst, int K, int N, const float* __restrict__ rowscale,
                   float cs_val, int cs_lo, int cs_hi, int kt, int nt, char* smem) {
  float* t = (float*)smem;
  const int tid = tid_();
#pragma unroll
  for (int i = 0; i < 16; ++i) {
    int k = i * 4 + (tid >> 6), n = tid & 63;
    int gk = kt * 64 + k, gn = nt * 64 + n;
    float v = 0.f;
    if (gn < N) {
      v = src[(long)gk * N + gn];
      if (rowscale) v *= rowscale[gk];
      if (gn >= cs_lo && gn < cs_hi) v *= cs_val;
    }
    t[k * 65 + n] = v;
  }
  __syncthreads();
#pragma unroll
  for (int i = 0; i < 16; ++i) {
    int n = i * 4 + (tid >> 6), k = tid & 63;
    dst[(long)(nt * 64 + n) * K + kt * 64 + k] = bf1(t[k * 65 + n]);
  }
  __syncthreads();
}

typedef const __attribute__((address_space(4))) float* CF;
DI void phase_wprep(const Params& p, CF rope_hi, CF rope_lo, char* smem, int part) {
  const int tid = tid_();
  const int nWin = 32 * 86, nWuq = 12 * 24, nWukv = 8 * 32, nWo = 32 * 32;
  const int perL = nWin + nWuq + nWukv + nWo;
  for (int it = blockIdx.x; it < 2 * perL; it += gridDim.x) {
    int l = it / perL, r = it % perL;
    if (((l == 0 && r < nWin) ? 0 : 1) != part) continue;
    if (r < nWin) {
      wprep_item(p.w_in + (long)l * DM * INW, p.winT + (long)l * INWP * DM, DM, INW, p.norm_w + l * DM,
                 0.125f * LOG2E, 1856, 2368, r / 86, r % 86, smem);
    } else if ((r -= nWin) < nWuq) {
      wprep_item(p.w_uq + (long)l * 768 * 1536, p.wuqT + (long)l * 1536 * 768, 768, 1536, p.q_norm + l * 768,
                 0.07216878364870322f * LOG2E, 0, 1536, r / 24, r % 24, smem);
    } else if ((r -= nWuq) < nWukv) {
      wprep_item(p.w_ukv + (long)l * 512 * 2048, p.wukvT + (long)l * 2048 * 512, 512, 2048, p.kv_norm + l * 512,
                 1.f, 0, 0, r / 32, r % 32, smem);
    } else {
      r -= nWukv;
      wprep_item(p.w_o + (long)l * DM * DM, p.woT + (long)l * DM * DM, DM, DM, nullptr, 1.f, 0, 0, r / 32, r % 32, smem);
    }
  }
  for (int it = blockIdx.x; it < (part == 1 ? 1024 : 0); it += gridDim.x) {
    int o = it * 256 + tid;
    int c = o & 127, n = (o >> 7) & 255, gg = (o >> 15) & 3, l = o >> 17;
    int d = n & 127, part = n >> 7;
    const float* W = p.w_fmix + (long)(l * 4 + gg) * 128 * 128;
    float s = 0.f;
    for (int cp = 0; cp < 128; ++cp) {
      float fr = (float)((c * cp) & 127) * (1.f / 128.f);
      float tr = part ? __builtin_amdgcn_sinf(fr) : __builtin_amdgcn_cosf(fr);
      s += tr * W[cp * 128 + d];
    }
    p.mfT[o] = bf1(s * 0.08838834764831845f);
  }
  for (int it = blockIdx.x; it < (part == 0 ? (8320 * 32) / 256 : 0); it += gridDim.x) {
    int o = it * 256 + tid;
    int c = o & 31, t = o >> 5;
    float tf = (float)t, hi = rope_hi[c], lo = rope_lo[c];
    float pr = tf * hi;
    float er = fmaf(tf, hi, -pr);
    float fr = (pr - floorf(pr)) + (er + tf * lo);
    p.rope[o] = make_float2(__builtin_amdgcn_cosf(fr), __builtin_amdgcn_sinf(fr));
  }
  if (part == 0 && blockIdx.x == 0 && tid < 128) p.ctr[tid] = 0;
  if (part == 0) {
    for (int i = blockIdx.x * NTHR + tid; i < 5 * 50432; i += gridDim.x * NTHR) p.rowsq[i] = 0.f;
    for (int gi = 0; gi < 2; ++gi) {
      const GroupP& g = p.grp[gi];
      const int npad = g.Lp - g.L;
      const int total = g.B * npad * (DM / 8);
      for (int i = blockIdx.x * NTHR + tid; i < total; i += gridDim.x * NTHR) {
        const int c = i % (DM / 8), rr = i / (DM / 8);
        const int b = rr / npad, t = g.L + (rr - b * npad);
        unsigned zz = 0u; asm volatile("" : "+v"(zz)); u32x4 z = {zz, zz, zz, zz};
        *(u32x4*)(g.h1b + ((long)(b * g.Lp + t)) * DM + c * 8) = z;
      }
    }
  }
  if (part == 1 && blockIdx.x == 0 && tid < 2) {
    int l = tid;
    float a = 0.f, b = 0.f;
    for (int i = 0; i < 64; ++i) {
      a += p.lq1[l * 64 + i] * p.lk1[l * 64 + i];
      b += p.lq2[l * 64 + i] * p.lk2[l * 64 + i];
    }
    float lam_init = l ? 0.35550906759f : 0.2f;
    p.lam[l] = __builtin_amdgcn_exp2f(a * LOG2E) - __builtin_amdgcn_exp2f(b * LOG2E) + lam_init;
  }
}

DI void phase_rowprep(const Params& p, const GroupP& g, int l, int vb) {
  const int tid = tid_(), lane = tid & 63, wid = __builtin_amdgcn_readfirstlane(tid >> 6);
  for (int it = vb; it < g.T / 4; it += gridDim.x) {
    int row = it * 4 + wid;
    int b = row / g.Lp, t = row - b * g.Lp;
    u16* dst = g.xb + (long)row * DM;
    if (t >= g.L) {
      unsigned zz = 0u; asm volatile("" : "+v"(zz)); u32x4 z = {zz, zz, zz, zz};
#pragma unroll
      for (int i = 0; i < 4; ++i) *(u32x4*)(dst + (i * 64 + lane) * 8) = z;
      continue;
    }
    if (l == 0) {
      const float* src = (t < 16) ? p.meta + t * DM : g.x + ((long)b * (g.L - 16) + (t - 16)) * DM;
      float4 v[8];
      float ss = 0.f;
#pragma unroll
      for (int i = 0; i < 8; ++i) {
        v[i] = *(const float4*)(src + (i * 64 + lane) * 4);
        ss += v[i].x * v[i].x + v[i].y * v[i].y + v[i].z * v[i].z + v[i].w * v[i].w;
      }
      ss = wave_sum(ss);
      float r = __builtin_amdgcn_rsqf(ss * (1.f / DM) + 1e-6f);
#pragma unroll
      for (int i = 0; i < 8; ++i) store_bf4(dst + (i * 64 + lane) * 4, v[i].x * r, v[i].y * r, v[i].z * r, v[i].w * r);
    } else {
      const u16* src = g.h1b + (long)row * DM;
      u32x4 v[4];
      float ss = 0.f;
#pragma unroll
      for (int i = 0; i < 4; ++i) {
        v[i] = *(const u32x4*)(src + (i * 64 + lane) * 8);
#pragma unroll
        for (int j = 0; j < 4; ++j) { float a = bf_lo(v[i][j]), c = bf_hi(v[i][j]); ss += a * a + c * c; }
      }
      ss = wave_sum(ss);
      float r = __builtin_amdgcn_rsqf(ss * (1.f / DM) + 1e-6f);
#pragma unroll
      for (int i = 0; i < 4; ++i) {
        u32x4 o;
#pragma unroll
        for (int j = 0; j < 4; ++j) o[j] = pk2(bf_lo(v[i][j]) * r, bf_hi(v[i][j]) * r);
        *(u32x4*)(dst + (i * 64 + lane) * 8) = o;
      }
    }
  }
}

DI void phase_dftfill(const GroupP& g, int vb) {
  const int tid = tid_();
  const int L = g.L, Lp = g.Lp, Hp = g.Hp, H = L >> 1;
  const float invL = 1.f / (float)L, nrm = 1.f / sqrtf((float)L);
  const int nch = (2 * Hp) / 8;
  const int krows = (Hp + 255) / 256 * 256;
  for (int k = vb; k < krows; k += gridDim.x) {
    u16* rowp = g.fm + (long)k * (2 * Hp);
    for (int ch = tid; ch < nch; ch += NTHR) {
      int kk0 = ch * 8;
      int part = kk0 >= Hp;
      int s0 = kk0 - part * Hp;
      float v[8];
      if (k > H) {
#pragma unroll
        for (int j = 0; j < 8; ++j) v[j] = 0.f;
      } else {
        unsigned prod = (unsigned)k * (unsigned)s0;
        int jj = (L == 8208) ? (int)(prod % 8208u) : (int)(prod % 4112u);
#pragma unroll
        for (int j = 0; j < 8; ++j) {
          float fr = (float)jj * invL;
          float tr = part ? -__builtin_amdgcn_sinf(fr) : __builtin_amdgcn_cosf(fr);
          v[j] = (s0 + j <= H) ? tr * nrm : 0.f;
          jj += k;
          if (jj >= L) jj -= L;
        }
      }
      u32x4 o;
      o[0] = pk2(v[0], v[1]); o[1] = pk2(v[2], v[3]); o[2] = pk2(v[4], v[5]); o[3] = pk2(v[6], v[7]);
      *(u32x4*)(rowp + kk0) = o;
    }
  }
}

DI void rope_store(const f32x16& a0, const f32x16& a1, const float2* __restrict__ ropet, u16* dst, int lh) {
#pragma unroll
  for (int gi = 0; gi < 4; ++gi) {
    int c0 = 8 * gi + 4 * lh;
    float4 t01 = *(const float4*)(ropet + c0);
    float4 t23 = *(const float4*)(ropet + c0 + 2);
    float cs[4] = {t01.x, t01.z, t23.x, t23.z};
    float sn[4] = {t01.y, t01.w, t23.y, t23.w};
    float o1[4], o2[4];
#pragma unroll
    for (int j = 0; j < 4; ++j) {
      float x1 = a0[4 * gi + j], x2 = a1[4 * gi + j];
      o1[j] = x1 * cs[j] - x2 * sn[j];
      o2[j] = x2 * cs[j] + x1 * sn[j];
    }
    store_bf4(dst + c0, o1[0], o1[1], o1[2], o1[3]);
    store_bf4(dst + 32 + c0, o2[0], o2[1], o2[2], o2[3]);
  }
}

DI void phase_inproj(const Params& p, const GroupP& g, int l, char* smem, int vb) {
  const int tid = tid_(), lane = tid & 63, wid = __builtin_amdgcn_readfirstlane(tid >> 6);
  const int wm = wid >> 1, wn = wid & 1, lr = lane & 31, lh = lane >> 5;
  const int nmt = g.T / 256;
  const u16* W = p.winT + (long)l * INWP * DM;
  const int ntiles = nmt * 43;
  for (int it = vb; it < ((ntiles + 7) & ~7); it += gridDim.x) {
    const int tt = xcd_tile(it, ntiles);
    if (tt < 0) continue;
    int nt, mt;
    tile_mn(tt, nmt, 43, mt, nt);
    int m0 = mt * 256, n0 = nt * 128;
    f32x16 acc[4][2];
    const u16* xb = (l == 0) ? g.xb : g.h1b;
    float rsd[4];
    gemm_main<true, false>([&](int kt) { return ASrc{xb + kt * 64, DM}; }, m0, W + (long)n0 * DM, DM, DM, smem, acc, 0.f, rsd);
    const int nw0 = n0 + wn * 64;
    if (nw0 >= INW) continue;
    if (l == 1) {
      const float* sq = p.rowsq + (size_t)4 * 50432 + g.seq0 + m0 + wm * 128 + lr;
#pragma unroll
      for (int mi = 0; mi < 4; ++mi) {
        const float r = __builtin_amdgcn_rsqf(sq[mi * 32] * (1.f / DM) + 1e-6f);
#pragma unroll
        for (int ni = 0; ni < 2; ++ni)
#pragma unroll
          for (int i = 0; i < 16; ++i) acc[mi][ni][i] *= r;
      }
    }
#pragma unroll
    for (int mi = 0; mi < 4; ++mi) {
      int m = m0 + wm * 128 + mi * 32 + lr;
      int b = m / g.Lp, t = m - b * g.Lp;
      if (nw0 == 1792) {
        rope_store(acc[mi][0], acc[mi][1], p.rope + t * 32, g.kr + (long)m * 64, lh);
      } else if (nw0 >= 2880 && nw0 < 3392) {
#pragma unroll
        for (int ni = 0; ni < 2; ++ni)
#pragma unroll
          for (int i = 0; i < 16; ++i) {
            const long uoff = (long)(nw0 - 2880 + ni * 32 + (i & 3) + 8 * (i >> 2)) * g.Lp * 2;
            const unsigned voff = (unsigned)(((b * 512 + 4 * lh) * g.Lp + t) * 2);
            *(u16*)((char*)g.vdt + uoff + voff) = bf1(acc[mi][ni][i]);
          }
      } else {
        u16* dst; int ld, base; bool sil = false;
        if (nw0 < 512) { dst = g.uf; ld = 512; base = 0; }
        else if (nw0 < 1280) { dst = g.cq; ld = 768; base = 512; }
        else if (nw0 < 1792) { dst = g.ckv; ld = 512; base = 1280; }
        else if (nw0 < 2368) { dst = g.qd; ld = 512; base = 1856; }
        else if (nw0 < 2880) { dst = g.kd; ld = 512; base = 2368; }
        else { dst = g.g; ld = 2048; base = 3392; sil = true; }
        if (nw0 >= 512 && nw0 < 1792) {
          float ss = 0.f;
#pragma unroll
          for (int ni = 0; ni < 2; ++ni)
#pragma unroll
            for (int i = 0; i < 16; ++i) ss += acc[mi][ni][i] * acc[mi][ni][i];
          atomicAdd(p.rowsq + (size_t)(l * 2 + (nw0 >= 1280 ? 1 : 0)) * 50432 + g.seq0 + m, ss);
        }
#pragma unroll
        for (int ni = 0; ni < 2; ++ni)
#pragma unroll
          for (int gi = 0; gi < 4; ++gi) {
            int n = nw0 - base + ni * 32 + 8 * gi + 4 * lh;
            float v0 = acc[mi][ni][4 * gi], v1 = acc[mi][ni][4 * gi + 1], v2 = acc[mi][ni][4 * gi + 2], v3 = acc[mi][ni][4 * gi + 3];
            if (sil) { v0 = silu(v0); v1 = silu(v1); v2 = silu(v2); v3 = silu(v3); }
            store_bf4(dst + (long)m * ld + n, v0, v1, v2, v3);
          }
      }
    }
  }
}

DI void phase_upproj(const Params& p, const GroupP& g, int l, char* smem, int vb) {
  const int tid = tid_(), lane = tid & 63, wid = __builtin_amdgcn_readfirstlane(tid >> 6);
  const int wm = wid >> 1, wn = wid & 1, lr = lane & 31, lh = lane >> 5;
  const int nmt = g.T / 256;
  u16* kn = g.xb;
  u16* vt = g.xb + (long)g.T * 1024;
  const int ntiles = nmt * 28;
  for (int it = vb; it < ((ntiles + 7) & ~7); it += gridDim.x) {
    const int tt = xcd_tile(it, ntiles);
    if (tt < 0) continue;
    int nt, mt;
    tile_mn(tt, nmt, 28, mt, nt);
    int m0 = mt * 256;
    f32x16 acc[4][2];
    float rs[4];
    if (nt < 28) {
      const bool isq = nt < 12;
      const int n0 = isq ? nt * 128 : (nt - 12) * 128;
      const u16* A = isq ? g.cq : g.ckv;
      const int Kd = isq ? 768 : 512;
      const u16* Bw = isq ? p.wuqT + (long)l * 1536 * 768 + (long)n0 * 768 : p.wukvT + (long)l * 2048 * 512 + (long)n0 * 512;
      gemm_main<true, false>([&](int kt) { return ASrc{A + kt * 64, (long)Kd}; }, m0, Bw, Kd, Kd, smem, acc, 0.f, rs);
      {
        const float* sq = p.rowsq + (size_t)(l * 2 + (isq ? 0 : 1)) * 50432 + g.seq0 + m0 + wm * 128 + lr;
        const float invK = 1.f / (float)Kd;
#pragma unroll
        for (int mi = 0; mi < 4; ++mi) rs[mi] = __builtin_amdgcn_rsqf(sq[mi * 32] * invK + 1e-6f);
      }
      const int nw0 = n0 + wn * 64;
      if (isq) {
        const int head = nw0 / 192, w = nw0 - head * 192;
#pragma unroll
        for (int mi = 0; mi < 4; ++mi) {
          int m = m0 + wm * 128 + mi * 32 + lr;
          float r = rs[mi];
          if (w == 128) {
            int b = m / g.Lp, t = m - b * g.Lp;
            f32x16 a0 = acc[mi][0], a1 = acc[mi][1];
#pragma unroll
            for (int i = 0; i < 16; ++i) { a0[i] *= r; a1[i] *= r; }
            rope_store(a0, a1, p.rope + t * 32, g.q + (long)m * 1536 + nw0, lh);
          } else {
            u16* qp = g.q + (long)m * 1536 + nw0 + 4 * lh;
#pragma unroll
            for (int ni = 0; ni < 2; ++ni)
#pragma unroll
              for (int gi = 0; gi < 4; ++gi)
                store_bf4(qp + ni * 32 + 8 * gi, acc[mi][ni][4 * gi] * r, acc[mi][ni][4 * gi + 1] * r,
                          acc[mi][ni][4 * gi + 2] * r, acc[mi][ni][4 * gi + 3] * r);
          }
        }
      } else {
        const int head = n0 >> 8, isv = (n0 >> 7) & 1;
        if (!isv) {
#pragma unroll
          for (int mi = 0; mi < 4; ++mi) {
            int m = m0 + wm * 128 + mi * 32 + lr;
            float r = rs[mi];
            u16* kp = kn + (long)m * 1024 + head * 128 + wn * 64 + 4 * lh;
#pragma unroll
            for (int ni = 0; ni < 2; ++ni)
#pragma unroll
              for (int gi = 0; gi < 4; ++gi)
                store_bf4(kp + ni * 32 + 8 * gi, acc[mi][ni][4 * gi] * r, acc[mi][ni][4 * gi + 1] * r,
                          acc[mi][ni][4 * gi + 2] * r, acc[mi][ni][4 * gi + 3] * r);
          }
        } else {
#pragma unroll
          for (int mi = 0; mi < 4; ++mi) {
            int m = m0 + wm * 128 + mi * 32 + lr;
            float r = rs[mi];
            int b = m / g.Lp, t = m - b * g.Lp;
            const unsigned voff = (unsigned)((((b * 8 + head) * 128 + 4 * lh) * g.Lp + t) * 2);
#pragma unroll
            for (int ni = 0; ni < 2; ++ni)
#pragma unroll
              for (int i = 0; i < 16; ++i) {
                const long uoff = (long)(wn * 64 + ni * 32 + (i & 3) + 8 * (i >> 2)) * g.Lp * 2;
                *(u16*)((char*)vt + uoff + voff) = bf1(acc[mi][ni][i] * r);
              }
          }
        }
      }
    }
  }
  {
    const int Hp = g.Hp, H = g.L >> 1, L = g.L, Lp = g.Lp;
    const int nft = (g.B * Hp) / 256;
    const int srow = tid >> 3, skc = tid & 7;
    char* sA = smem;
    char* sB = smem + 256 * 144;
    for (int it = vb; it < nft * 8; it += gridDim.x) {
      const int nt = it / nft, mt = it - nt * nft;
      const int m0 = mt * 256, n0 = nt * 128;
      const int gg = n0 >> 8, part = (n0 >> 7) & 1;
      const u16* Bw = p.mfT + (long)(l * 4 + gg) * 256 * 128 + (long)(n0 & 255) * 128;
      f32x16 acc[4][2];
#pragma unroll
      for (int mi = 0; mi < 4; ++mi)
#pragma unroll
        for (int ni = 0; ni < 2; ++ni)
#pragma unroll
          for (int i = 0; i < 16; ++i) acc[mi][ni][i] = 0.f;
      for (int kt = 0; kt < 2; ++kt) {
#pragma unroll
        for (int i = 0; i < 8; ++i) {
          const int row = srow + 32 * i;
          const int m = m0 + row;
          const int b = m / Hp, sidx = m - b * Hp;
          const bool pair = sidx >= 1 && sidx < H;
          const bool v1ok = (sidx <= H) && (pair || !part);
          u32x4 v1 = {0u, 0u, 0u, 0u}, v2 = {0u, 0u, 0u, 0u};
          if (v1ok) v1 = *(const u32x4*)(g.uf + ((long)(b * Lp + sidx)) * 512 + gg * 128 + kt * 64 + skc * 8);
          if (pair) v2 = *(const u32x4*)(g.uf + ((long)(b * Lp + L - sidx)) * 512 + gg * 128 + kt * 64 + skc * 8);
          u32x4 o;
#pragma unroll
          for (int j = 0; j < 4; ++j) {
            float a0 = bf_lo(v1[j]), a1 = bf_hi(v1[j]), b0 = bf_lo(v2[j]), b1 = bf_hi(v2[j]);
            o[j] = part ? pk2(a0 - b0, a1 - b1) : pk2(a0 + b0, a1 + b1);
          }
          *(u32x4*)(sA + row * 144 + skc * 16) = o;
        }
#pragma unroll
        for (int i = 0; i < 4; ++i)
          *(u32x4*)(sB + (srow + 32 * i) * 144 + skc * 16) = *(const u32x4*)(Bw + (long)(srow + 32 * i) * 128 + kt * 64 + skc * 8);
        __syncthreads();
#pragma unroll
        for (int ks = 0; ks < 4; ++ks) {
          bf16x8 af[4], bfr[2];
#pragma unroll
          for (int mi = 0; mi < 4; ++mi) af[mi] = *(const bf16x8*)(sA + (wm * 128 + mi * 32 + lr) * 144 + ks * 32 + lh * 16);
#pragma unroll
          for (int ni = 0; ni < 2; ++ni) bfr[ni] = *(const bf16x8*)(sB + (wn * 64 + ni * 32 + lr) * 144 + ks * 32 + lh * 16);
#pragma unroll
          for (int mi = 0; mi < 4; ++mi)
#pragma unroll
            for (int ni = 0; ni < 2; ++ni) acc[mi][ni] = MFMA(af[mi], bfr[ni], acc[mi][ni]);
        }
        __syncthreads();
      }
#pragma unroll
      for (int mi = 0; mi < 4; ++mi)
#pragma unroll
        for (int gi = 0; gi < 4; ++gi) {
          const int m = m0 + wm * 128 + mi * 32 + 8 * gi + 4 * lh;
          const int b = m / Hp, sidx = m - b * Hp;
#pragma unroll
          for (int ni = 0; ni < 2; ++ni) {
            const int d = wn * 64 + ni * 32 + lr;
            store_bf4(g.abt + ((long)(b * 512 + gg * 128 + d)) * (2 * Hp) + part * Hp + sidx, acc[mi][ni][4 * gi],
                      acc[mi][ni][4 * gi + 1], acc[mi][ni][4 * gi + 2], acc[mi][ni][4 * gi + 3]);
          }
        }
    }
  }
}

constexpr float SM_THR = 8.f;
DI void softmax_pv(f32x16 (&sa)[2], f32x16 (&O)[4], float& m, float& l, const char* sV, int lr, int lh, bool first) {
  float t0 = fmaxf(fmaxf(sa[0][0], sa[0][1]), sa[0][2]);
  float t1 = fmaxf(fmaxf(sa[1][0], sa[1][1]), sa[1][2]);
#pragma unroll
  for (int i = 3; i < 15; i += 2) {
    t0 = fmaxf(fmaxf(t0, sa[0][i]), sa[0][i + 1]);
    t1 = fmaxf(fmaxf(t1, sa[1][i]), sa[1][i + 1]);
  }
  float tmax = fmaxf(fmaxf(t0, t1), fmaxf(sa[0][15], sa[1][15]));
  tmax = fmaxf(tmax, __shfl_xor(tmax, 32, 64));
  if (first || __any(tmax > SM_THR)) {
    asm volatile("; rescale" ::: "memory");
    const float delta = first ? tmax : fmaxf(tmax, 0.f);
    const float alpha = __builtin_amdgcn_exp2f(-delta);
    m += delta;
    l *= alpha;
#pragma unroll
    for (int d = 0; d < 4; ++d)
#pragma unroll
      for (int i = 0; i < 16; ++i) O[d][i] *= alpha;
#pragma unroll
    for (int i = 0; i < 16; ++i) { sa[0][i] -= delta; sa[1][i] -= delta; }
  }
  float rsum0 = 0.f, rsum1 = 0.f;
#pragma unroll
  for (int i = 0; i < 16; ++i) {
    float p0 = __builtin_amdgcn_exp2f(sa[0][i]);
    float p1 = __builtin_amdgcn_exp2f(sa[1][i]);
    sa[0][i] = p0;
    sa[1][i] = p1;
    rsum0 += p0;
    rsum1 += p1;
  }
  l += rsum0 + rsum1;
  bf16x8 pf[4];
#pragma unroll
  for (int g4 = 0; g4 < 4; ++g4) {
    const int kb = g4 >> 1, s2 = g4 & 1;
    u32x4 pp;
#pragma unroll
    for (int j = 0; j < 4; ++j) pp[j] = pk2(sa[kb][8 * s2 + 2 * j], sa[kb][8 * s2 + 2 * j + 1]);
    pf[g4] = __builtin_bit_cast(bf16x8, pp);
  }
  const char* vrd = sV + lr * 144 + lh * 16;
  bf16x8 vfr[4];
#pragma unroll
  for (int t = 0; t < 3; ++t) vfr[t] = *(const bf16x8*)(vrd + (t & 3) * (32 * 144) + (t >> 2) * 32);
  __builtin_amdgcn_sched_group_barrier(0x100, 3, 0);
#pragma unroll
  for (int t = 0; t < 16; ++t) {
    if (t + 3 < 16) {
      vfr[(t + 3) & 3] = *(const bf16x8*)(vrd + ((t + 3) & 3) * (32 * 144) + ((t + 3) >> 2) * 32);
      __builtin_amdgcn_sched_group_barrier(0x100, 1, 0);
    }
    O[t & 3] = MFMA(vfr[t & 3], pf[t >> 2], O[t & 3]);
    __builtin_amdgcn_sched_group_barrier(0x008, 1, 0);
  }
}

DI void load_vtile(u32x4 (&rv)[4], const u16* __restrict__ vbase, int Lp, int key0, unsigned voffV) {
  const char* ub = (const char*)vbase + (long)key0 * 2;
#pragma unroll
  for (int i = 0; i < 4; ++i) rv[i] = *(const u32x4*)(ub + (long)(32 * i) * Lp * 2 + voffV);
}
DI void store_vtile(const u32x4 (&rv)[4], char* sVst) {
#pragma unroll
  for (int i = 0; i < 4; ++i) {
    u32x2 lo = {rv[i][0], rv[i][1]}, hi = {rv[i][2], rv[i][3]};
    *(u32x2*)(sVst + i * 4608) = lo;
    *(u32x2*)(sVst + i * 4608 + 16) = hi;
  }
}

DI void mla_item(const Params& p, const GroupP& g, int item, char* smem, bool dry) {
  const int tid = tid_(), lane = tid & 63, wid = __builtin_amdgcn_readfirstlane(tid >> 6), lr = lane & 31, lh = lane >> 5;
  const int nqb = g.Lp / 128;
  const int qb = item % nqb, bh = item / nqb, h = bh & 7, b = bh >> 3;
  const int Lp = g.Lp, L = g.L;
  char* sK = smem;
  char* sV = smem + 64 * 400;
  const u16* kn = g.xb + (long)b * Lp * 1024 + h * 128;
  const u16* kr = g.kr + (long)b * Lp * 64;
  const u16* vbase = g.xb + (long)g.T * 1024 + (long)(b * 8 + h) * 128 * Lp;
  const int qrow = b * Lp + qb * 128 + wid * 32 + lr;
  bf16x8 qf[12];
#pragma unroll
  for (int ks = 0; ks < 12; ++ks) qf[ks] = *(const bf16x8*)(g.q + (long)qrow * 1536 + h * 192 + ks * 16 + lh * 8);
  f32x16 O[4];
#pragma unroll
  for (int d = 0; d < 4; ++d)
#pragma unroll
    for (int i = 0; i < 16; ++i) O[d][i] = 0.f;
  float m = 0.f, l = 0.f;
  const int nkt = (L + 63) >> 6;
  u32x4 rk[6], rv[4];
  const unsigned voffKn = (unsigned)((tid >> 4) * 2048 + (tid & 15) * 16);
  const unsigned voffKr = (unsigned)((tid >> 3) * 128 + (tid & 7) * 16);
  const unsigned voffV = (unsigned)(((tid >> 3) * Lp + (tid & 7) * 8) * 2);
  char* sKn_st = sK + (tid >> 4) * 400 + (tid & 15) * 16;
  char* sKr_st = sK + (tid >> 3) * 400 + 256 + (tid & 7) * 16;
  char* sV_st = sV + (tid >> 3) * 144 + ((tid & 7) >> 1) * 32 + (tid & 1) * 8;
  auto loadK = [&](int kt) {
    const char* u1 = (const char*)kn + (long)kt * (64 * 2048);
#pragma unroll
    for (int i = 0; i < 4; ++i) rk[i] = *(const u32x4*)(u1 + i * (16 * 2048) + voffKn);
    const char* u2 = (const char*)kr + (long)kt * (64 * 128);
#pragma unroll
    for (int i = 0; i < 2; ++i) rk[4 + i] = *(const u32x4*)(u2 + i * (32 * 128) + voffKr);
  };
  auto storeK = [&]() {
#pragma unroll
    for (int i = 0; i < 4; ++i) *(u32x4*)(sKn_st + i * 6400) = rk[i];
#pragma unroll
    for (int i = 0; i < 2; ++i) *(u32x4*)(sKr_st + i * 12800) = rk[4 + i];
  };
  loadK(0);
  load_vtile(rv, vbase, Lp, 0, voffV);
  storeK();
  store_vtile(rv, sV_st);
  __syncthreads();
  for (int kt = 0; kt < nkt; ++kt) {
    const bool more = kt + 1 < nkt;
    if (more) loadK(kt + 1);
    __builtin_amdgcn_sched_barrier(0);
    f32x16 sa[2];
#pragma unroll
    for (int i = 0; i < 16; ++i) { sa[0][i] = -m; sa[1][i] = -m; }
    {
      const char* krd = sK + lr * 400 + lh * 16;
      bf16x8 kf[3][2];
#pragma unroll
      for (int q2 = 0; q2 < 2; ++q2) {
        kf[q2][0] = *(const bf16x8*)(krd + q2 * 32);
        kf[q2][1] = *(const bf16x8*)(krd + 32 * 400 + q2 * 32);
      }
      __builtin_amdgcn_sched_group_barrier(0x100, 4, 0);
#pragma unroll
      for (int ks = 0; ks < 12; ++ks) {
        if (ks + 2 < 12) {
          kf[(ks + 2) % 3][0] = *(const bf16x8*)(krd + (ks + 2) * 32);
          kf[(ks + 2) % 3][1] = *(const bf16x8*)(krd + 32 * 400 + (ks + 2) * 32);
          __builtin_amdgcn_sched_group_barrier(0x100, 2, 0);
        }
        sa[0] = MFMA(kf[ks % 3][0], qf[ks], sa[0]);
        sa[1] = MFMA(kf[ks % 3][1], qf[ks], sa[1]);
        __builtin_amdgcn_sched_group_barrier(0x008, 2, 0);
      }
    }
    if (kt == nkt - 1) {
      asm volatile("; masked tail tile" ::: "memory");
#pragma unroll
      for (int kb = 0; kb < 2; ++kb)
#pragma unroll
        for (int i = 0; i < 16; ++i)
          if (kt * 64 + kb * 32 + crow(i, lh) >= L) sa[kb][i] = -1e30f;
    }
    __syncthreads();
    if (more) { storeK(); load_vtile(rv, vbase, Lp, (kt + 1) * 64, voffV); }
    __builtin_amdgcn_sched_barrier(0);
    softmax_pv(sa, O, m, l, sV, lr, lh, kt == 0);
    __syncthreads();
    if (more) store_vtile(rv, sV_st);
  }
  float lt = l + __shfl_xor(l, 32, 64);
  float inv = 1.f / lt;
  const u16* gp = g.g + (long)qrow * 2048 + 512 + h * 128;
  u16* op = (dry ? (u16*)g.out : g.q) + (long)qrow * 1536 + h * 192;
#pragma unroll
  for (int d = 0; d < 4; ++d)
#pragma unroll
    for (int gi = 0; gi < 4; ++gi) {
      int dd = d * 32 + 8 * gi + 4 * lh;
      u32x2 gv = *(const u32x2*)(gp + dd);
      store_bf4(op + dd, O[d][4 * gi] * inv * bf_lo(gv[0]), O[d][4 * gi + 1] * inv * bf_hi(gv[0]),
                O[d][4 * gi + 2] * inv * bf_lo(gv[1]), O[d][4 * gi + 3] * inv * bf_hi(gv[1]));
    }
  __syncthreads();
}

DI int t5_bucket(int rel) {
  int n = rel < 0 ? -rel : rel;
  int bk;
  if (n < 8) bk = n;
  else if (n < 12) bk = 8;
  else if (n < 16) bk = 9;
  else if (n < 23) bk = 10;
  else if (n < 32) bk = 11;
  else if (n < 46) bk = 12;
  else if (n < 64) bk = 13;
  else if (n < 91) bk = 14;
  else bk = 15;
  return bk + (rel > 0 ? 16 : 0);
}

DI void diff_item(const Params& p, const GroupP& g, int l_layer, int item, char* smem, bool dry) {
  const int tid = tid_(), lane = tid & 63, wid = __builtin_amdgcn_readfirstlane(tid >> 6), lr = lane & 31, lh = lane >> 5;
  const int nqb = (g.L + 63) / 64;
  const int qb = item % nqb, bh = item / nqb, h = bh & 3, b = bh >> 2;
  const int Lp = g.Lp, L = g.L;
  const int map = wid >> 1, qs = wid & 1;
  char* sK = smem;
  char* sV = smem + 64 * 272;
  float* sBias = (float*)(smem + 64 * 272 + 128 * 144);
  float* o2buf = (float*)smem;
  const u16* kd = g.kd + (long)b * Lp * 512 + h * 128;
  const u16* vbase = g.vdt + (long)(b * 4 + h) * 128 * Lp;
  const int qpos = qb * 64 + qs * 32 + lr;
  const long qrow = (long)b * Lp + qpos;
  for (int i = tid; i < 257; i += NTHR) sBias[i] = p.rel_bias[t5_bucket(i - 128) * 4 + h] * LOG2E;
  const float bneg = p.rel_bias[15 * 4 + h] * LOG2E, bpos = p.rel_bias[31 * 4 + h] * LOG2E;
  bf16x8 qf[4];
#pragma unroll
  for (int ks = 0; ks < 4; ++ks) qf[ks] = *(const bf16x8*)(g.qd + qrow * 512 + h * 128 + map * 64 + ks * 16 + lh * 8);
  f32x16 O[4];
#pragma unroll
  for (int d = 0; d < 4; ++d)
#pragma unroll
    for (int i = 0; i < 16; ++i) O[d][i] = 0.f;
  float m = 0.f, l = 0.f;
  const int nkt = (L + 63) >> 6;
  u32x4 rk[4], rv[4];
  const unsigned voffK = (unsigned)((tid >> 4) * 1024 + (tid & 15) * 16);
  const unsigned voffV = (unsigned)(((tid >> 3) * Lp + (tid & 7) * 8) * 2);
  char* sK_st = sK + (tid >> 4) * 272 + (tid & 15) * 16;
  char* sV_st = sV + (tid >> 3) * 144 + ((tid & 7) >> 1) * 32 + (tid & 1) * 8;
  auto loadK = [&](int kt) {
    const char* u1 = (const char*)kd + (long)kt * (64 * 1024);
#pragma unroll
    for (int i = 0; i < 4; ++i) rk[i] = *(const u32x4*)(u1 + i * (16 * 1024) + voffK);
  };
  auto storeK = [&]() {
#pragma unroll
    for (int i = 0; i < 4; ++i) *(u32x4*)(sK_st + i * (16 * 272)) = rk[i];
  };
  const int qw0 = qb * 64 + qs * 32;
  loadK(0);
  load_vtile(rv, vbase, Lp, 0, voffV);
  storeK();
  store_vtile(rv, sV_st);
  __syncthreads();
  for (int kt = 0; kt < nkt; ++kt) {
    const bool more = kt + 1 < nkt;
    if (more) loadK(kt + 1);
    __builtin_amdgcn_sched_barrier(0);
    const int key0 = kt * 64;
    const int relmin = key0 - (qw0 + 31), relmax = key0 + 63 - qw0;
    const bool farp = relmin >= 128, farn = relmax <= -128;
    const float binit = (farp ? bpos : (farn ? bneg : 0.f)) - m;
    f32x16 sa[2];
#pragma unroll
    for (int i = 0; i < 16; ++i) { sa[0][i] = binit; sa[1][i] = binit; }
    {
      const char* krd = sK + lr * 272 + map * 128 + lh * 16;
      bf16x8 kf[4][2];
#pragma unroll
      for (int ks = 0; ks < 4; ++ks) {
        kf[ks][0] = *(const bf16x8*)(krd + ks * 32);
        kf[ks][1] = *(const bf16x8*)(krd + 32 * 272 + ks * 32);
      }
#pragma unroll
      for (int ks = 0; ks < 4; ++ks) {
        sa[0] = MFMA(kf[ks][0], qf[ks], sa[0]);
        sa[1] = MFMA(kf[ks][1], qf[ks], sa[1]);
      }
    }
    if (!farp && !farn) {
      asm volatile("; near-diagonal bias tile" ::: "memory");
#pragma unroll
      for (int kb = 0; kb < 2; ++kb)
#pragma unroll
        for (int i = 0; i < 16; ++i) {
          int rel = key0 + kb * 32 + crow(i, lh) - qpos;
          rel = rel < -128 ? -128 : (rel > 128 ? 128 : rel);
          sa[kb][i] += sBias[rel + 128];
        }
    }
    if (kt == nkt - 1) {
      asm volatile("; masked tail tile" ::: "memory");
#pragma unroll
      for (int kb = 0; kb < 2; ++kb)
#pragma unroll
        for (int i = 0; i < 16; ++i)
          if (key0 + kb * 32 + crow(i, lh) >= L) sa[kb][i] = -1e30f;
    }
    __syncthreads();
    if (more) { storeK(); load_vtile(rv, vbase, Lp, (kt + 1) * 64, voffV); }
    __builtin_amdgcn_sched_barrier(0);
    softmax_pv(sa, O, m, l, sV, lr, lh, kt == 0);
    __syncthreads();
    if (more) store_vtile(rv, sV_st);
  }
  float lt = l + __shfl_xor(l, 32, 64);
  float inv = 1.f / lt;
  if (map == 1) {
#pragma unroll
    for (int d = 0; d < 4; ++d)
#pragma unroll
      for (int i = 0; i < 16; ++i) o2buf[(d * 32 + crow(i, lh)) * 64 + qs * 32 + lr] = O[d][i] * inv;
  }
  __syncthreads();
  if (map == 0) {
    const float lam = p.lam[l_layer];
    const float lam_init = l_layer ? 0.35550906759f : 0.2f;
    float ss = 0.f;
#pragma unroll
    for (int d = 0; d < 4; ++d)
#pragma unroll
      for (int i = 0; i < 16; ++i) {
        float o = O[d][i] * inv - lam * o2buf[(d * 32 + crow(i, lh)) * 64 + qs * 32 + lr];
        O[d][i] = o;
        ss += o * o;
      }
    ss += __shfl_xor(ss, 32, 64);
    float r = __builtin_amdgcn_rsqf(ss * (1.f / 128.f) + 1e-5f) * (1.f - lam_init);
    const u16* gp = g.g + qrow * 2048 + 1536 + h * 128;
    const float* dn = p.diff_norm + l_layer * 128;
    u16* op = (dry ? (u16*)g.out + (long)g.T * 1536 : g.qd) + qrow * 512 + h * 128;
#pragma unroll
    for (int d = 0; d < 4; ++d)
#pragma unroll
      for (int gi = 0; gi < 4; ++gi) {
        int dd = d * 32 + 8 * gi + 4 * lh;
        u32x2 gv = *(const u32x2*)(gp + dd);
        float4 w = *(const float4*)(dn + dd);
        store_bf4(op + dd, O[d][4 * gi] * r * w.x * bf_lo(gv[0]), O[d][4 * gi + 1] * r * w.y * bf_hi(gv[0]),
                  O[d][4 * gi + 2] * r * w.z * bf_lo(gv[1]), O[d][4 * gi + 3] * r * w.w * bf_hi(gv[1]));
      }
  }
  __syncthreads();
}

DI float* dft_part(const GroupP& g, int part) { return (float*)g.cq + (size_t)part * g.B * g.Hp * 512; }
DI void dft_item(const Params& p, const GroupP& g, int item, char* smem) {
  const int tid = tid_(), lane = tid & 63, wid = __builtin_amdgcn_readfirstlane(tid >> 6);
  const int wm = wid >> 1, wn = wid & 1, lr = lane & 31, lh = lane >> 5;
  const int nb8 = g.B * 8;
  int mt = item / nb8, r = item - mt * nb8;
  int b = r >> 3, nt = (r >> 1) & 3, part = r & 1;
  int m0 = mt * 256, n0 = nt * 128;
  const int Hp = g.Hp, K2 = 2 * Hp;
  f32x16 acc[4][2];
  const u16* A = g.fm + part * Hp;
  float rsd[4];
  gemm_main<true, false>([&](int kt) { return ASrc{A + kt * 64, (long)K2}; }, m0, g.abt + ((long)b * 512 + n0) * K2 + part * Hp, K2, Hp, smem, acc, 0.f, rsd);
  float* dst = dft_part(g, part) + (size_t)b * Hp * 512;
#pragma unroll
  for (int mi = 0; mi < 4; ++mi) {
    int mm = m0 + wm * 128 + mi * 32 + lr;
    if (mm >= Hp) continue;
#pragma unroll
    for (int ni = 0; ni < 2; ++ni)
#pragma unroll
      for (int gi = 0; gi < 4; ++gi) {
        int n = n0 + wn * 64 + ni * 32 + 8 * gi + 4 * lh;
        float4 o = {acc[mi][ni][4 * gi], acc[mi][ni][4 * gi + 1], acc[mi][ni][4 * gi + 2], acc[mi][ni][4 * gi + 3]};
        *(float4*)(dst + (size_t)mm * 512 + n) = o;
      }
  }
}

DI void phase_dftfin(const GroupP& g, int vb) {
  const int tid = tid_();
  const int H = g.L >> 1, Hp = g.Hp, L = g.L, Lp = g.Lp;
  const float* P = dft_part(g, 0);
  const float* Q = dft_part(g, 1);
  const int total = g.B * (H + 1) * 128;
  for (int i = vb * NTHR + tid; i < total; i += gridDim.x * NTHR) {
    const int c = i & 127, rk = i >> 7;
    const int b = rk / (H + 1), k = rk - b * (H + 1);
    const size_t src = ((size_t)b * Hp + k) * 512 + c * 4;
    const float4 pv = *(const float4*)(P + src);
    const float4 qv = *(const float4*)(Q + src);
    const long row1 = (long)b * Lp + k;
    const u32x2 g1 = *(const u32x2*)(g.g + row1 * 2048 + c * 4);
    store_bf4(g.uf + row1 * 512 + c * 4, (pv.x + qv.x) * bf_lo(g1[0]), (pv.y + qv.y) * bf_hi(g1[0]), (pv.z + qv.z) * bf_lo(g1[1]),
              (pv.w + qv.w) * bf_hi(g1[1]));
    if (k >= 1 && k < H) {
      const long row2 = (long)b * Lp + (L - k);
      const u32x2 g2 = *(const u32x2*)(g.g + row2 * 2048 + c * 4);
      store_bf4(g.uf + row2 * 512 + c * 4, (pv.x - qv.x) * bf_lo(g2[0]), (pv.y - qv.y) * bf_hi(g2[0]), (pv.z - qv.z) * bf_lo(g2[1]),
                (pv.w - qv.w) * bf_hi(g2[1]));
    }
  }
}

DI int pad8(int n) { return (n + 7) & ~7; }

DI void phase_mix(const Params& p, int l, char* smem, int xcc) {
  const GroupP& ga = p.grp[0];
  const GroupP& gb = p.grp[1];
  int* s_item = (int*)(smem + SMEM_BYTES - 16);
  const int G = gridDim.x;
  {
    const int nDft1 = gb.B * ((gb.Hp + 255) / 256) * 8;
    const int nDft0 = ga.B * ((ga.Hp + 255) / 256) * 8;
    for (int it = blockIdx.x; it < pad8(nDft1); it += G) {
      const int tt = xcd_tile(it, nDft1);
      if (tt >= 0) dft_item(p, gb, tt, smem);
    }
    const int vb = (blockIdx.x + G - pad8(nDft1) % G) % G;
    for (int it = vb; it < pad8(nDft0); it += G) {
      const int tt = xcd_tile(it, nDft0);
      if (tt >= 0) dft_item(p, ga, tt, smem);
    }
  }
  const int nqbMa = ga.Lp / 128, nqbDa = (ga.L + 63) / 64, nqbMb = gb.Lp / 128, nqbDb = (gb.L + 63) / 64;
  const int nMa = ga.B * nqbMa, nDa = (ga.B >> 1) * nqbDa;
  const int nMb = gb.B * nqbMb, nDb = (gb.B >> 1) * nqbDb;
  const int e0 = nMa, e1 = e0 + nDa, e2 = e1 + nMb, perX = e2 + nDb;
  int* ctrb = p.ctr + l * 8;
  for (int steal = 0; steal < 8; ++steal) {
    const int q = (xcc + steal) & 7;
    for (;;) {
      if (threadIdx.x == 0) *s_item = atomicAdd(&ctrb[q], 1);
      __syncthreads();
      const int j = *s_item;
      __syncthreads();
      if (j >= perX) break;
      if (j < e0) {
        const int pl = j / nqbMa, qb = j - pl * nqbMa;
        mla_item(p, ga, (q + 8 * pl) * nqbMa + qb, smem, false);
      } else if (j < e1) {
        const int jj = j - e0;
        const int pl = jj / nqbDa, qb = jj - pl * nqbDa;
        diff_item(p, ga, l, (q + 8 * pl) * nqbDa + qb, smem, false);
      } else if (j < e2) {
        const int jj = j - e1;
        const int pl = jj / nqbMb, qb = jj - pl * nqbMb;
        mla_item(p, gb, (q + 8 * pl) * nqbMb + qb, smem, false);
      } else {
        const int jj = j - e2;
        const int pl = jj / nqbDb, qb = jj - pl * nqbDb;
        diff_item(p, gb, l, (q + 8 * pl) * nqbDb + qb, smem, false);
      }
    }
  }
}

DI void phase_outproj(const Params& p, const GroupP& g, int l, char* smem, int vb) {
  const int tid = tid_(), lane = tid & 63, wid = __builtin_amdgcn_readfirstlane(tid >> 6);
  const int wm = wid >> 1, wn = wid & 1, lr = lane & 31, lh = lane >> 5;
  const int nmt = g.T / 256;
  const u16* W = p.woT + (long)l * DM * DM;
  const int ntiles = nmt * 16;
  for (int it = vb; it < ((ntiles + 7) & ~7); it += gridDim.x) {
    const int tt = xcd_tile(it, ntiles);
    if (tt < 0) continue;
    int nt, mt;
    tile_mn(tt, nmt, 16, mt, nt);
    int m0 = mt * 256, n0 = nt * 128;
    f32x16 acc[4][2];
    const u16 *uf = g.uf, *q = g.q, *qd = g.qd;
    float rsd[4];
    gemm_main<true, false>(
        [&](int kt) {
          int k0 = kt * 64;
          if (k0 < 512) return ASrc{uf + k0, 512};
          if (k0 < 1536) { int kk = k0 - 512; return ASrc{q + (kk >> 7) * 192 + (kk & 127), 1536}; }
          return ASrc{qd + (k0 - 1536), 512};
        },
        m0, W + (long)n0 * DM, DM, DM, smem, acc, 0.f, rsd);
#pragma unroll
    for (int mi = 0; mi < 4; ++mi) {
      int m = m0 + wm * 128 + mi * 32 + lr;
      int b = m / g.Lp, t = m - b * g.Lp;
      if (t >= g.L) continue;
      if (l == 0) {
        const float* res = (t < 16) ? p.meta + t * DM : g.x + ((long)b * (g.L - 16) + (t - 16)) * DM;
        u16* dst = g.h1b + (long)m * DM;
        float ss = 0.f;
#pragma unroll
        for (int ni = 0; ni < 2; ++ni)
#pragma unroll
          for (int gi = 0; gi < 4; ++gi) {
            int n = n0 + wn * 64 + ni * 32 + 8 * gi + 4 * lh;
            float4 rv = *(const float4*)(res + n);
            const float a0 = rv.x + acc[mi][ni][4 * gi], a1 = rv.y + acc[mi][ni][4 * gi + 1];
            const float a2 = rv.z + acc[mi][ni][4 * gi + 2], a3 = rv.w + acc[mi][ni][4 * gi + 3];
            store_bf4(dst + n, a0, a1, a2, a3);
            ss += a0 * a0 + a1 * a1 + a2 * a2 + a3 * a3;
          }
        atomicAdd(p.rowsq + (size_t)4 * 50432 + g.seq0 + m, ss);
      } else {
        if (t < 16) continue;
        const u16* res = g.h1b + (long)m * DM;
        float* dst = g.out + ((long)b * (g.L - 16) + (t - 16)) * DM;
#pragma unroll
        for (int ni = 0; ni < 2; ++ni)
#pragma unroll
          for (int gi = 0; gi < 4; ++gi) {
            int n = n0 + wn * 64 + ni * 32 + 8 * gi + 4 * lh;
            u32x2 rv = *(const u32x2*)(res + n);
            float4 o = {bf_lo(rv[0]) + acc[mi][ni][4 * gi], bf_hi(rv[0]) + acc[mi][ni][4 * gi + 1],
                        bf_lo(rv[1]) + acc[mi][ni][4 * gi + 2], bf_hi(rv[1]) + acc[mi][ni][4 * gi + 3]};
            *(float4*)(dst + n) = o;
          }
      }
    }
  }
}

DI void phase_final(const Params& p) {
  const int tid = tid_(), lane = tid & 63, wid = __builtin_amdgcn_readfirstlane(tid >> 6);
  const int rows0 = p.grp[0].B * (p.grp[0].L - 16), rows1 = p.grp[1].B * (p.grp[1].L - 16);
  for (int it = blockIdx.x; it < (rows0 + rows1) / 4; it += gridDim.x) {
    int row = it * 4 + wid;
    float* ptr = (row < rows0) ? p.grp[0].out + (long)row * DM : p.grp[1].out + (long)(row - rows0) * DM;
    float4 v[8];
    float ss = 0.f;
#pragma unroll
    for (int i = 0; i < 8; ++i) {
      v[i] = *(const float4*)(ptr + (i * 64 + lane) * 4);
      ss += v[i].x * v[i].x + v[i].y * v[i].y + v[i].z * v[i].z + v[i].w * v[i].w;
    }
    ss = wave_sum(ss);
    float r = __builtin_amdgcn_rsqf(ss * (1.f / DM) + 1e-6f);
#pragma unroll
    for (int i = 0; i < 8; ++i) {
      float4 w = *(const float4*)(p.final_norm + (i * 64 + lane) * 4);
      float4 o = {v[i].x * r * w.x, v[i].y * r * w.y, v[i].z * r * w.z, v[i].w * r * w.w};
      *(float4*)(ptr + (i * 64 + lane) * 4) = o;
    }
  }
}

#define XB_TMO      128
#define XB_XCNT(j)  (256  + 64 * (j))
#define XB_XSUB(j)  (1280 + 64 * (j))
#define XB_XGEN(j)  (2304 + 64 * (j))
#define XB_TOP      3328
#define XB_TOPGEN   3392
#define XCD_BAR_WORDS 3456
#define XB_SPIN_CAP (1u << 22)
#define LAS __attribute__((address_space(3)))
DI unsigned xb_ld(unsigned* p) { return __hip_atomic_load(p, __ATOMIC_RELAXED, __HIP_MEMORY_SCOPE_AGENT); }
DI unsigned xb_add(unsigned* p, unsigned v) { return __hip_atomic_fetch_add(p, v, __ATOMIC_RELAXED, __HIP_MEMORY_SCOPE_AGENT); }
DI unsigned xb_xcc_id() { return (unsigned)__builtin_amdgcn_s_getreg((3 << 11) | 20) & 0xFu; }
#define XB_SPIN(cond, bar) do { unsigned _sp = 0; while (cond) { __builtin_amdgcn_s_sleep(1); \
    if ((++_sp & 255u) == 0u) { if (xb_ld(&(bar)[XB_TMO])) break; if (_sp > XB_SPIN_CAP) { atomicAdd(&(bar)[XB_TMO], 1u); break; } } } } while (0)
struct XcdBarrier { unsigned* bar; unsigned x; volatile LAS unsigned* st; };
DI XcdBarrier xcd_barrier_post(unsigned* bar, volatile LAS unsigned* st) {
  XcdBarrier b; b.bar = bar; b.x = xb_xcc_id(); b.st = st;
  if (threadIdx.x == 0) (void)xb_add(&bar[XB_XCNT(b.x)], 1u);
  return b;
}
DI void xcd_barrier_complete(unsigned* bar, unsigned x, unsigned& nloc, unsigned& nx) {
  const unsigned G = gridDim.x * gridDim.y * gridDim.z;
  unsigned sum, cnt, mine, sp = 0u;
  for (;;) {
    sum = 0u; cnt = 0u; mine = 0u;
#pragma unroll
    for (unsigned j = 0; j < 16; ++j) { const unsigned c = xb_ld(&bar[XB_XCNT(j)]); sum += c; cnt += (c > 0u) ? 1u : 0u; mine = (j == x) ? c : mine; }
    if (sum == G) break;
    __builtin_amdgcn_s_sleep(1);
    if ((++sp & 255u) == 0u) { if (xb_ld(&bar[XB_TMO])) break; if (sp > XB_SPIN_CAP) { atomicAdd(&bar[XB_TMO], 1u); break; } }
  }
  nloc = mine > 0u ? mine : 1u; nx = cnt > 0u ? cnt : 1u;
}
DI void xcd_barrier(const XcdBarrier& b) {
  asm volatile("s_waitcnt vmcnt(0)" ::: "memory");
  __syncthreads();
  if (threadIdx.x == 0) {
    unsigned* bar = b.bar;
    __builtin_amdgcn_s_waitcnt(0);
    unsigned nloc = b.st[0], nx = b.st[1];
    if (nloc == 0u) { xcd_barrier_complete(bar, b.x, nloc, nx); b.st[0] = nloc; b.st[1] = nx; }
    const unsigned old = xb_add(&bar[XB_XSUB(b.x)], 1u);
    const unsigned gen = old / nloc;
    if (old + 1u == (gen + 1u) * nloc) {
      __builtin_amdgcn_fence(__ATOMIC_RELEASE, "agent");
      asm volatile("s_waitcnt vmcnt(0)" ::: "memory");
      const unsigned og = xb_add(&bar[XB_TOP], 1u);
      const unsigned tg = og / nx;
      if (og + 1u == (tg + 1u) * nx) xb_add(&bar[XB_TOPGEN], 1u);
      else XB_SPIN(xb_ld(&bar[XB_TOPGEN]) == tg, bar);
      __builtin_amdgcn_fence(__ATOMIC_ACQUIRE, "agent");
      xb_add(&bar[XB_XGEN(b.x)], 1u);
      asm volatile("s_waitcnt vmcnt(0)" ::: "memory");
    } else {
      XB_SPIN(xb_ld(&bar[XB_XGEN(b.x)]) == gen, bar);
      __builtin_amdgcn_fence(__ATOMIC_ACQUIRE, "agent");
      asm volatile("s_waitcnt vmcnt(0)" ::: "memory");
    }
  }
  __syncthreads();
}

constexpr int NPHASE = 12;

__global__ void __launch_bounds__(NTHR, 2) mega(Params p_unused, int ph_lo, int ph_hi) {
  __shared__ __attribute__((aligned(16))) char smem[SMEM_BYTES];
  __shared__ uint4 xb_words;
  if (threadIdx.x == 0) xb_words = make_uint4(0u, 0u, 0u, 0u);
  __syncthreads();
  {
    typedef const __attribute__((address_space(4))) Params* CPP0;
    CPP0 kp0 = (CPP0)__builtin_amdgcn_kernarg_segment_ptr();
    (void)xcd_barrier_post(kp0->bar, (volatile LAS unsigned*)&xb_words);
  }
  for (int ph = ph_lo; ph < ph_hi; ++ph) {
    typedef const __attribute__((address_space(4))) char* CP;
    CP kq = (CP)__builtin_amdgcn_kernarg_segment_ptr();
    asm volatile("" : "+s"(kq));
    typedef const __attribute__((address_space(4))) Params* CPP;
    CPP kp = (CPP)kq;
    Params p;
    p.grp[0].x = kp->grp[0].x;
    p.grp[0].out = kp->grp[0].out;
    p.grp[0].B = kp->grp[0].B;
    p.grp[0].L = kp->grp[0].L;
    p.grp[0].Lp = kp->grp[0].Lp;
    p.grp[0].T = kp->grp[0].T;
    p.grp[0].seq0 = kp->grp[0].seq0;
    p.grp[0].Hp = kp->grp[0].Hp;
    p.grp[0].xb = kp->grp[0].xb;
    p.grp[0].uf = kp->grp[0].uf;
    p.grp[0].cq = kp->grp[0].cq;
    p.grp[0].ckv = kp->grp[0].ckv;
    p.grp[0].kr = kp->grp[0].kr;
    p.grp[0].qd = kp->grp[0].qd;
    p.grp[0].kd = kp->grp[0].kd;
    p.grp[0].vdt = kp->grp[0].vdt;
    p.grp[0].g = kp->grp[0].g;
    p.grp[0].q = kp->grp[0].q;
    p.grp[0].abt = kp->grp[0].abt;
    p.grp[0].fm = kp->grp[0].fm;
    p.grp[0].h1b = kp->grp[0].h1b;
    p.grp[1].x = kp->grp[1].x;
    p.grp[1].out = kp->grp[1].out;
    p.grp[1].B = kp->grp[1].B;
    p.grp[1].L = kp->grp[1].L;
    p.grp[1].Lp = kp->grp[1].Lp;
    p.grp[1].T = kp->grp[1].T;
    p.grp[1].seq0 = kp->grp[1].seq0;
    p.grp[1].Hp = kp->grp[1].Hp;
    p.grp[1].xb = kp->grp[1].xb;
    p.grp[1].uf = kp->grp[1].uf;
    p.grp[1].cq = kp->grp[1].cq;
    p.grp[1].ckv = kp->grp[1].ckv;
    p.grp[1].kr = kp->grp[1].kr;
    p.grp[1].qd = kp->grp[1].qd;
    p.grp[1].kd = kp->grp[1].kd;
    p.grp[1].vdt = kp->grp[1].vdt;
    p.grp[1].g = kp->grp[1].g;
    p.grp[1].q = kp->grp[1].q;
    p.grp[1].abt = kp->grp[1].abt;
    p.grp[1].fm = kp->grp[1].fm;
    p.grp[1].h1b = kp->grp[1].h1b;
    p.meta = kp->meta;
    p.rel_bias = kp->rel_bias;
    p.final_norm = kp->final_norm;
    p.norm_w = kp->norm_w;
    p.w_in = kp->w_in;
    p.w_fmix = kp->w_fmix;
    p.q_norm = kp->q_norm;
    p.w_uq = kp->w_uq;
    p.kv_norm = kp->kv_norm;
    p.w_ukv = kp->w_ukv;
    p.lq1 = kp->lq1;
    p.lk1 = kp->lk1;
    p.lq2 = kp->lq2;
    p.lk2 = kp->lk2;
    p.diff_norm = kp->diff_norm;
    p.w_o = kp->w_o;
    p.winT = kp->winT;
    p.wuqT = kp->wuqT;
    p.wukvT = kp->wukvT;
    p.woT = kp->woT;
    p.mfT = kp->mfT;
    p.rope = kp->rope;
    p.lam = kp->lam;
    p.hmeta = kp->hmeta;
    p.ctr = kp->ctr;
    p.bar = kp->bar;
    p.rowsq = kp->rowsq;
    if (ph == 11) {
      phase_final(p);
    } else {
      const int l = ph >= 6 ? 1 : 0, st = ph >= 6 ? ph - 5 : ph;
      const GroupP& g0 = p.grp[0];
      const GroupP& g1 = p.grp[1];
      const int G = gridDim.x, bid = blockIdx.x;
      if (st == 0) {
        if (ph == 0) phase_wprep(p, &kp->rope_hi[0], &kp->rope_lo[0], smem, 0);
        phase_rowprep(p, g1, l, bid);
        phase_rowprep(p, g0, l, (bid + G - (g1.T / 4) % G) % G);
      } else if (st == 1) {
        phase_inproj(p, g1, l, smem, bid);
        phase_inproj(p, g0, l, smem, (bid + G - pad8((g1.T / 256) * 43) % G) % G);
        if (l == 0) {
          phase_wprep(p, &kp->rope_hi[0], &kp->rope_lo[0], smem, 1);
          phase_dftfill(g1, G - 1 - bid);
          phase_dftfill(g0, G - 1 - bid);
        }
      } else if (st == 2) {
        phase_upproj(p, g1, l, smem, bid);
        phase_upproj(p, g0, l, smem, (bid + G - pad8((g1.T / 256) * 28) % G) % G);
      } else if (st == 3) {
        phase_mix(p, l, smem, (int)(xb_xcc_id() & 7u));
      } else if (st == 4) {
        phase_dftfin(g1, bid);
        phase_dftfin(g0, bid);
      } else {
        phase_outproj(p, g1, l, smem, bid);
        phase_outproj(p, g0, l, smem, (bid + G - pad8((g1.T / 256) * 16) % G) % G);
      }
    }
    if (ph + 1 < ph_hi) {
      XcdBarrier xb;
      xb.bar = p.bar; xb.x = xb_xcc_id(); xb.st = (volatile LAS unsigned*)&xb_words;
      xcd_barrier(xb);
    }
    if (ph_hi == 0x7fffffff) cg::this_grid().sync();
  }
}

extern "C" void kernel_launch(void* const* d_in, const int* in_sizes, int n_in, void* d_out, int out_size, void* d_ws,
                              size_t ws_size, hipStream_t stream) {
  Params p;
  memset(&p, 0, sizeof(p));
  const float* x_prompt = (const float*)d_in[0];
  const float* x_sample = (const float*)d_in[1];
  p.meta = (const float*)d_in[2];
  p.rel_bias = (const float*)d_in[3];
  p.final_norm = (const float*)d_in[4];
  p.norm_w = (const float*)d_in[5];
  p.w_in = (const float*)d_in[6];
  p.w_fmix = (const float*)d_in[7];
  p.q_norm = (const float*)d_in[8];
  p.w_uq = (const float*)d_in[9];
  p.kv_norm = (const float*)d_in[10];
  p.w_ukv = (const float*)d_in[11];
  p.lq1 = (const float*)d_in[12];
  p.lk1 = (const float*)d_in[13];
  p.lq2 = (const float*)d_in[14];
  p.lk2 = (const float*)d_in[15];
  p.diff_norm = (const float*)d_in[16];
  p.w_o = (const float*)d_in[17];

  for (int c = 0; c < 32; ++c) {
    double inv = pow(10000.0, -(double)c / 32.0) / (2.0 * 3.14159265358979323846);
    float hi = (float)inv;
    p.rope_hi[c] = hi;
    p.rope_lo[c] = (float)(inv - (double)hi);
  }
  char* ws = (char*)d_ws;
  size_t off = 0;
  auto take = [&](size_t bytes) { char* r = ws + off; off += (bytes + 255) & ~(size_t)255; return r; };
  p.winT = (u16*)take((size_t)2 * INWP * DM * 2);
  p.wuqT = (u16*)take((size_t)2 * 1536 * 768 * 2);
  p.wukvT = (u16*)take((size_t)2 * 2048 * 512 * 2);
  p.woT = (u16*)take((size_t)2 * DM * DM * 2);
  p.mfT = (u16*)take((size_t)2 * 4 * 256 * 128 * 2);
  p.rope = (float2*)take((size_t)8320 * 32 * 8);
  p.lam = (float*)take(256);
  p.hmeta = (float*)take((size_t)10 * 16 * DM * 4);
  p.ctr = (int*)take(1024);
  p.bar = (unsigned*)take(XCD_BAR_WORDS * 4);
  p.rowsq = (float*)take((size_t)5 * 50432 * 4);
  char* os = (char*)d_out;
  size_t ooff = 0;
  auto otake = [&](size_t bytes) { char* r = os + ooff; ooff += (bytes + 255) & ~(size_t)255; return r; };
  for (int gi = 0; gi < 2; ++gi) {
    GroupP& g = p.grp[gi];
    g.B = gi == 0 ? 2 : 8;
    int S = gi == 0 ? 8192 : 4096;
    g.L = S + 16;
    g.Lp = (g.L + 127) / 128 * 128;
    g.T = g.B * g.Lp;
    g.Hp = (g.L / 2 + 1 + 127) / 128 * 128;
    g.seq0 = gi == 0 ? 0 : 16640;
    g.x = gi == 0 ? x_prompt : x_sample;
    g.out = (float*)d_out + (gi == 0 ? 0 : (size_t)2 * 8192 * DM);
    size_t T = g.T;
    g.xb = (u16*)otake(T * 2048 * 2);
    g.cq = (u16*)otake(T * 768 * 2);
    g.ckv = (u16*)otake(T * 512 * 2);
    g.kr = (u16*)otake(T * 64 * 2);
    g.kd = (u16*)otake(T * 512 * 2);
    g.uf = (u16*)take(T * 512 * 2);
    g.qd = (u16*)take(T * 512 * 2);
    g.vdt = (u16*)take(T * 512 * 2);
    g.g = (u16*)take(T * 2048 * 2);
    g.q = (u16*)take(T * 1536 * 2);
    g.h1b = (u16*)take(T * 2048 * 2);
    g.abt = (u16*)take((size_t)g.B * 512 * 2 * g.Hp * 2);
    g.fm = (u16*)take((size_t)((g.Hp + 255) / 256 * 256) * 2 * g.Hp * 2);
  }
  const size_t need = off;
  if (need > ws_size || ooff > (size_t)out_size * 4) {
    fprintf(stderr, "workspace too small: need %zu have %zu (out scratch %zu of %zu)\n", need, ws_size, ooff, (size_t)out_size * 4);
    return;
  }

  static int grid_blocks = 0;
  if (!grid_blocks) {
    int dev = 0, cus = 0, per_cu = 0;
    hipGetDevice(&dev);
    hipDeviceGetAttribute(&cus, hipDeviceAttributeMultiprocessorCount, dev);
    hipOccupancyMaxActiveBlocksPerMultiprocessor(&per_cu, mega, NTHR, 0);
    if (per_cu < 1) per_cu = 1;
    if (per_cu > 2) per_cu = 2;
    grid_blocks = cus * per_cu;
  }
  hipMemsetAsync(p.bar, 0, XCD_BAR_WORDS * 4, stream);
#if COOP
  int lo = 0, hi = NPHASE;
  void* args[] = {&p, &lo, &hi};
  hipError_t e = hipLaunchCooperativeKernel((void*)mega, dim3(grid_blocks), dim3(NTHR), args, 0, stream);
  if (e != hipSuccess) fprintf(stderr, "cooperative launch failed: %s (grid %d)\n", hipGetErrorString(e), grid_blocks);
#else
  for (int ph = 0; ph < NPHASE; ++ph) mega<<<grid_blocks, NTHR, 0, stream>>>(p, ph, ph + 1);
#endif
}
```

```cpp
#include <hip/hip_runtime.h>
#include <hip/hip_cooperative_groups.h>
#include <cstdio>
#include <cstring>
#include <cmath>
namespace cg = cooperative_groups;

#ifndef COOP
#define COOP 1
#endif

typedef unsigned short u16;
using bf16x8 = __attribute__((ext_vector_type(8))) short;
using f32x16 = __attribute__((ext_vector_type(16))) float;
using u32x4 = __attribute__((ext_vector_type(4))) unsigned;
using u32x2 = __attribute__((ext_vector_type(2))) unsigned;
#define DI __device__ __forceinline__
#define MFMA(a, b, c) __builtin_amdgcn_mfma_f32_32x32x16_bf16((a), (b), (c), 0, 0, 0)

constexpr int DM = 2048;
constexpr int INW = 5440;
constexpr int INWP = 5504;
constexpr float LOG2E = 1.4426950408889634f;
constexpr int NTHR = 256;
constexpr int SMEM_BYTES = 256 * 144 + 128 * 144 + 1024;

struct GroupP {
  const float* x;
  float* out;
  int B, L, Lp, T;
  int seq0, Hp;
  u16 *xb, *uf, *cq, *ckv, *kr, *qd, *kd, *vdt, *g, *q, *abt, *fm;
  u16* h1b;
};
struct Params {
  GroupP grp[2];
  const float *meta, *rel_bias, *final_norm, *norm_w, *w_in, *w_fmix, *q_norm, *w_uq, *kv_norm, *w_ukv;
  const float *lq1, *lk1, *lq2, *lk2, *diff_norm, *w_o;
  u16 *winT, *wuqT, *wukvT, *woT, *mfT;
  float2* rope;
  float* lam;
  float* hmeta;
  int* ctr;
  unsigned* bar;
  float* rowsq;
  float rope_hi[32], rope_lo[32];
};

DI unsigned pk2(float lo, float hi) {
  typedef __bf16 bf2 __attribute__((ext_vector_type(2)));
  typedef float f2 __attribute__((ext_vector_type(2)));
  f2 v = {lo, hi};
  return __builtin_bit_cast(unsigned, __builtin_convertvector(v, bf2));
}
DI u16 bf1(float x) { return (u16)(pk2(x, 0.f) & 0xffffu); }
DI float bf_lo(unsigned u) { return __uint_as_float(u << 16); }
DI float bf_hi(unsigned u) { return __uint_as_float(u & 0xffff0000u); }
DI int tid_() { int t = threadIdx.x; asm volatile("" : "+v"(t)); return t; }
DI int crow(int i, int h) { return (i & 3) + 8 * (i >> 2) + 4 * h; }
DI float wave_sum(float v) {
#pragma unroll
  for (int o = 32; o >= 1; o >>= 1) v += __shfl_xor(v, o, 64);
  return v;
}

struct ASrc { const u16* p; long ld; };

DI float dot2bf(unsigned a, float c) {
  typedef __bf16 bf2 __attribute__((ext_vector_type(2)));
  bf2 x = __builtin_bit_cast(bf2, a);
  return __builtin_amdgcn_fdot2_f32_bf16(x, x, c, false);
}

template <bool SWAP, bool SSQ, class AF>
DI void gemm_main(AF asrc, int m0, const u16* __restrict__ Bw, int ldb, int K, char* smem,
                  f32x16 (&acc)[4][2], float ssq_eps, float (&rs)[4]) {
  const int tid = tid_(), lane = tid & 63, wid = __builtin_amdgcn_readfirstlane(tid >> 6);
  const int wm = wid >> 1, wn = wid & 1, lr = lane & 31, lh = lane >> 5;
  char* sA = smem;
  char* sB = smem + 256 * 144;
  const int srow = tid >> 3, skc = tid & 7;
  const unsigned lds_st = srow * 144 + skc * 16;
  const unsigned voffB = (unsigned)(srow * ldb * 2 + skc * 16);
  u32x4 ra[8], rb[4];
#pragma unroll
  for (int i = 0; i < 4; ++i) rs[i] = 0.f;
#pragma unroll
  for (int mi = 0; mi < 4; ++mi)
#pragma unroll
    for (int ni = 0; ni < 2; ++ni)
#pragma unroll
      for (int i = 0; i < 16; ++i) acc[mi][ni][i] = 0.f;

  auto gload = [&](int kt) {
    ASrc s = asrc(kt);
    const unsigned voffA = (unsigned)(srow * (int)s.ld * 2 + skc * 16);
    const char* ua = (const char*)s.p + (long)m0 * s.ld * 2;
#pragma unroll
    for (int i = 0; i < 8; ++i) ra[i] = *(const u32x4*)(ua + (long)(32 * i) * s.ld * 2 + voffA);
    const char* ub = (const char*)Bw + (long)kt * 128;
#pragma unroll
    for (int i = 0; i < 4; ++i) rb[i] = *(const u32x4*)(ub + (long)(32 * i) * ldb * 2 + voffB);
  };
  auto sstore = [&]() {
#pragma unroll
    for (int i = 0; i < 8; ++i) *(u32x4*)(sA + lds_st + i * (32 * 144)) = ra[i];
#pragma unroll
    for (int i = 0; i < 4; ++i) *(u32x4*)(sB + lds_st + i * (32 * 144)) = rb[i];
  };

  const int nkt = K >> 6;
  const char* pA = sA + (wm * 128 + lr) * 144 + lh * 16;
  const char* pB = sB + (wn * 64 + lr) * 144 + lh * 16;
  gload(0);
  sstore();
  __syncthreads();
  for (int kt = 0; kt < nkt; ++kt) {
    if (kt + 1 < nkt) gload(kt + 1);
    __builtin_amdgcn_sched_barrier(0);
    {
      bf16x8 ar[3], br[2][2];
      ar[0] = *(const bf16x8*)(pA);
      ar[1] = *(const bf16x8*)(pA + 32 * 144);
      br[0][0] = *(const bf16x8*)(pB);
      br[0][1] = *(const bf16x8*)(pB + 32 * 144);
      __builtin_amdgcn_sched_group_barrier(0x100, 4, 0);
#pragma unroll
      for (int t = 0; t < 16; ++t) {
        const int ks = t >> 2, mi = t & 3;
        if (t + 2 < 16) {
          ar[(t + 2) % 3] = *(const bf16x8*)(pA + ((t + 2) & 3) * (32 * 144) + ((t + 2) >> 2) * 32);
          if (mi == 1 && ks + 1 < 4) {
            br[(ks + 1) & 1][0] = *(const bf16x8*)(pB + (ks + 1) * 32);
            br[(ks + 1) & 1][1] = *(const bf16x8*)(pB + 32 * 144 + (ks + 1) * 32);
            __builtin_amdgcn_sched_group_barrier(0x100, 3, 0);
          } else {
            __builtin_amdgcn_sched_group_barrier(0x100, 1, 0);
          }
        }
        acc[mi][0] = SWAP ? MFMA(br[ks & 1][0], ar[t % 3], acc[mi][0]) : MFMA(ar[t % 3], br[ks & 1][0], acc[mi][0]);
        acc[mi][1] = SWAP ? MFMA(br[ks & 1][1], ar[t % 3], acc[mi][1]) : MFMA(ar[t % 3], br[ks & 1][1], acc[mi][1]);
        __builtin_amdgcn_sched_group_barrier(0x008, 2, 0);
        if (SSQ) {
          u32x4 u = __builtin_bit_cast(u32x4, ar[t % 3]);
#pragma unroll
          for (int j = 0; j < 4; ++j) rs[mi] = dot2bf(u[j], rs[mi]);
        }
      }
    }
    __syncthreads();
    if (kt + 1 < nkt) sstore();
    __syncthreads();
  }
  if (SSQ) {
#pragma unroll
    for (int mi = 0; mi < 4; ++mi) {
      float v = rs[mi] + __shfl_xor(rs[mi], 32, 64);
      rs[mi] = __builtin_amdgcn_rsqf(v / (float)K + ssq_eps);
    }
  }
}

DI int xcd_tile(int it, int total) {
  const int per = (total + 7) >> 3;
  const int j = it >> 3;
  const int t = (it & 7) * per + j;
  return (j < per && t < total) ? t : -1;
}
constexpr int TGM = 4;
DI void tile_mn(int t, int nmt, int nnt, int& mt, int& nt) {
  const int gs = TGM * nnt;
  const int mg = t / gs, r = t - mg * gs;
  const int rem = nmt - mg * TGM;
  const int gsz = rem < TGM ? rem : TGM;
  nt = r / gsz;
  mt = mg * TGM + (r - nt * gsz);
}

DI float silu(float x) { return x * __builtin_amdgcn_rcpf(1.f + __builtin_amdgcn_exp2f(-x * LOG2E)); }

DI void store_bf8_pair(u16* p16, int lh, float a0, float a1, float a2, float a3, float b0, float b1, float b2, float b3) {
  const unsigned pa0 = pk2(a0, a1), pa1 = pk2(a2, a3), pb0 = pk2(b0, b1), pb1 = pk2(b2, b3);
  auto r0 = __builtin_amdgcn_permlane32_swap(pa0, pb0, false, false);
  auto r1 = __builtin_amdgcn_permlane32_swap(pa1, pb1, false, false);
  u32x4 w = {r0[0], r1[0], r0[1], r1[1]};
  *(u32x4*)(p16 + 8 * lh) = w;
}

DI void store_bf4(u16* dst, float a, float b, float c, float d) {
  u32x2 v;
  v[0] = pk2(a, b);
  v[1] = pk2(c, d);
  *(u32x2*)dst = v;
}

DI void wprep_item(const float* __restrict__ src, u16* __restrict__ dst, int K, int N, const float* __restrict__ rowscale,
                   float cs_val, int cs_lo, int cs_hi, int kt, int nt, char* smem) {
  float* t = (float*)smem;
  const int tid = tid_();
#pragma unroll
  for (int i = 0; i < 16; ++i) {
    int k = i * 4 + (tid >> 6), n = tid & 63;
    int gk = kt * 64 + k, gn = nt * 64 + n;
    float v = 0.f;
    if (gn < N) {
      v = src[(long)gk * N + gn];
      if (rowscale) v *= rowscale[gk];
      if (gn >= cs_lo && gn < cs_hi) v *= cs_val;
    }
    t[k * 65 + n] = v;
  }
  __syncthreads();
#pragma unroll
  for (int i = 0; i < 16; ++i) {
    int n = i * 4 + (tid >> 6), k = tid & 63;
    dst[(long)(nt * 64 + n) * K + kt * 64 + k] = bf1(t[k * 65 + n]);
  }
  __syncthreads();
}

typedef const __attribute__((address_space(4))) float* CF;
DI void phase_wprep(const Params& p, CF rope_hi, CF rope_lo, char* smem, int part) {
  const int tid = tid_();
  const int nWin = 32 * 86, nWuq = 12 * 24, nWukv = 8 * 32, nWo = 32 * 32;
  const int perL = nWin + nWuq + nWukv + nWo;
  for (int it = blockIdx.x; it < 2 * perL; it += gridDim.x) {
    int l = it / perL, r = it % perL;
    if (((l == 0 && r < nWin) ? 0 : 1) != part) continue;
    if (r < nWin) {
      wprep_item(p.w_in + (long)l * DM * INW, p.winT + (long)l * INWP * DM, DM, INW, p.norm_w + l * DM,
                 0.125f * LOG2E, 1856, 2368, r / 86, r % 86, smem);
    } else if ((r -= nWin) < nWuq) {
      wprep_item(p.w_uq + (long)l * 768 * 1536, p.wuqT + (long)l * 1536 * 768, 768, 1536, p.q_norm + l * 768,
                 0.07216878364870322f * LOG2E, 0, 1536, r / 24, r % 24, smem);
    } else if ((r -= nWuq) < nWukv) {
      wprep_item(p.w_ukv + (long)l * 512 * 2048, p.wukvT + (long)l * 2048 * 512, 512, 2048, p.kv_norm + l * 512,
                 1.f, 0, 0, r / 32, r % 32, smem);
    } else {
      r -= nWukv;
      wprep_item(p.w_o + (long)l * DM * DM, p.woT + (long)l * DM * DM, DM, DM, nullptr, 1.f, 0, 0, r / 32, r % 32, smem);
    }
  }
  for (int it = blockIdx.x; it < (part == 1 ? 1024 : 0); it += gridDim.x) {
    int o = it * 256 + tid;
    int c = o & 127, n = (o >> 7) & 255, gg = (o >> 15) & 3, l = o >> 17;
    int d = n & 127, part = n >> 7;
    const float* W = p.w_fmix + (long)(l * 4 + gg) * 128 * 128;
    float s = 0.f;
    for (int cp = 0; cp < 128; ++cp) {
      float fr = (float)((c * cp) & 127) * (1.f / 128.f);
      float tr = part ? __builtin_amdgcn_sinf(fr) : __builtin_amdgcn_cosf(fr);
      s += tr * W[cp * 128 + d];
    }
    p.mfT[o] = bf1(s * 0.08838834764831845f);
  }
  for (int it = blockIdx.x; it < (part == 0 ? (8320 * 32) / 256 : 0); it += gridDim.x) {
    int o = it * 256 + tid;
    int c = o & 31, t = o >> 5;
    float tf = (float)t, hi = rope_hi[c], lo = rope_lo[c];
    float pr = tf * hi;
    float er = fmaf(tf, hi, -pr);
    float fr = (pr - floorf(pr)) + (er + tf * lo);
    p.rope[o] = make_float2(__builtin_amdgcn_cosf(fr), __builtin_amdgcn_sinf(fr));
  }
  if (part == 0 && blockIdx.x == 0 && tid < 128) p.ctr[tid] = 0;
  if (part == 0) {
    for (int i = blockIdx.x * NTHR + tid; i < 5 * 50432; i += gridDim.x * NTHR) p.rowsq[i] = 0.f;
    for (int gi = 0; gi < 2; ++gi) {
      const GroupP& g = p.grp[gi];
      const int npad = g.Lp - g.L;
      const int total = g.B * npad * (DM / 8);
      for (int i = blockIdx.x * NTHR + tid; i < total; i += gridDim.x * NTHR) {
        const int c = i % (DM / 8), rr = i / (DM / 8);
        const int b = rr / npad, t = g.L + (rr - b * npad);
        unsigned zz = 0u; asm volatile("" : "+v"(zz)); u32x4 z = {zz, zz, zz, zz};
        *(u32x4*)(g.h1b + ((long)(b * g.Lp + t)) * DM + c * 8) = z;
      }
    }
  }
  if (part == 1 && blockIdx.x == 0 && tid < 2) {
    int l = tid;
    float a = 0.f, b = 0.f;
    for (int i = 0; i < 64; ++i) {
      a += p.lq1[l * 64 + i] * p.lk1[l * 64 + i];
      b += p.lq2[l * 64 + i] * p.lk2[l * 64 + i];
    }
    float lam_init = l ? 0.35550906759f : 0.2f;
    p.lam[l] = __builtin_amdgcn_exp2f(a * LOG2E) - __builtin_amdgcn_exp2f(b * LOG2E) + lam_init;
  }
}

DI void phase_rowprep(const Params& p, const GroupP& g, int l, int vb) {
  const int tid = tid_(), lane = tid & 63, wid = __builtin_amdgcn_readfirstlane(tid >> 6);
  for (int it = vb; it < g.T / 4; it += gridDim.x) {
    int row = it * 4 + wid;
    int b = row / g.Lp, t = row - b * g.Lp;
    u16* dst = g.xb + (long)row * DM;
    if (t >= g.L) {
      unsigned zz = 0u; asm volatile("" : "+v"(zz)); u32x4 z = {zz, zz, zz, zz};
#pragma unroll
      for (int i = 0; i < 4; ++i) *(u32x4*)(dst + (i * 64 + lane) * 8) = z;
      continue;
    }
    if (l == 0) {
      const float* src = (t < 16) ? p.meta + t * DM : g.x + ((long)b * (g.L - 16) + (t - 16)) * DM;
      float4 v[8];
      float ss = 0.f;
#pragma unroll
      for (int i = 0; i < 8; ++i) {
        v[i] = *(const float4*)(src + (i * 64 + lane) * 4);
        ss += v[i].x * v[i].x + v[i].y * v[i].y + v[i].z * v[i].z + v[i].w * v[i].w;
      }
      ss = wave_sum(ss);
      float r = __builtin_amdgcn_rsqf(ss * (1.f / DM) + 1e-6f);
#pragma unroll
      for (int i = 0; i < 8; ++i) store_bf4(dst + (i * 64 + lane) * 4, v[i].x * r, v[i].y * r, v[i].z * r, v[i].w * r);
    } else {
      const u16* src = g.h1b + (long)row * DM;
      u32x4 v[4];
      float ss = 0.f;
#pragma unroll
      for (int i = 0; i < 4; ++i) {
        v[i] = *(const u32x4*)(src + (i * 64 + lane) * 8);
#pragma unroll
        for (int j = 0; j < 4; ++j) { float a = bf_lo(v[i][j]), c = bf_hi(v[i][j]); ss += a * a + c * c; }
      }
      ss = wave_sum(ss);
      float r = __builtin_amdgcn_rsqf(ss * (1.f / DM) + 1e-6f);
#pragma unroll
      for (int i = 0; i < 4; ++i) {
        u32x4 o;
#pragma unroll
        for (int j = 0; j < 4; ++j) o[j] = pk2(bf_lo(v[i][j]) * r, bf_hi(v[i][j]) * r);
        *(u32x4*)(dst + (i * 64 + lane) * 8) = o;
      }
    }
  }
}

DI void phase_dftfill(const GroupP& g, int vb) {
  const int tid = tid_();
  const int L = g.L, Lp = g.Lp, Hp = g.Hp, H = L >> 1;
  const float invL = 1.f / (float)L, nrm = 1.f / sqrtf((float)L);
  const int nch = (2 * Hp) / 8;
  const int krows = (Hp + 255) / 256 * 256;
  for (int k = vb; k < krows; k += gridDim.x) {
    u16* rowp = g.fm + (long)k * (2 * Hp);
    for (int ch = tid; ch < nch; ch += NTHR) {
      int kk0 = ch * 8;
      int part = kk0 >= Hp;
      int s0 = kk0 - part * Hp;
      float v[8];
      if (k > H) {
#pragma unroll
        for (int j = 0; j < 8; ++j) v[j] = 0.f;
      } else {
        unsigned prod = (unsigned)k * (unsigned)s0;
        int jj = (L == 8208) ? (int)(prod % 8208u) : (int)(prod % 4112u);
#pragma unroll
        for (int j = 0; j < 8; ++j) {
          float fr = (float)jj * invL;
          float tr = part ? -__builtin_amdgcn_sinf(fr) : __builtin_amdgcn_cosf(fr);
          v[j] = (s0 + j <= H) ? tr * nrm : 0.f;
          jj += k;
          if (jj >= L) jj -= L;
        }
      }
      u32x4 o;
      o[0] = pk2(v[0], v[1]); o[1] = pk2(v[2], v[3]); o[2] = pk2(v[4], v[5]); o[3] = pk2(v[6], v[7]);
      *(u32x4*)(rowp + kk0) = o;
    }
  }
}

DI void rope_store(const f32x16& a0, const f32x16& a1, const float2* __restrict__ ropet, u16* dst, int lh) {
#pragma unroll
  for (int pr = 0; pr < 2; ++pr) {
    float o1[2][4], o2[2][4];
#pragma unroll
    for (int e = 0; e < 2; ++e) {
      const int gi = 2 * pr + e;
      const int c0 = 8 * gi + 4 * lh;
      float4 t01 = *(const float4*)(ropet + c0);
      float4 t23 = *(const float4*)(ropet + c0 + 2);
      float cs[4] = {t01.x, t01.z, t23.x, t23.z};
      float sn[4] = {t01.y, t01.w, t23.y, t23.w};
#pragma unroll
      for (int j = 0; j < 4; ++j) {
        float x1 = a0[4 * gi + j], x2 = a1[4 * gi + j];
        o1[e][j] = x1 * cs[j] - x2 * sn[j];
        o2[e][j] = x2 * cs[j] + x1 * sn[j];
      }
    }
    store_bf8_pair(dst + 16 * pr, lh, o1[0][0], o1[0][1], o1[0][2], o1[0][3], o1[1][0], o1[1][1], o1[1][2], o1[1][3]);
    store_bf8_pair(dst + 32 + 16 * pr, lh, o2[0][0], o2[0][1], o2[0][2], o2[0][3], o2[1][0], o2[1][1], o2[1][2], o2[1][3]);
  }
}

DI void phase_inproj(const Params& p, const GroupP& g, int l, char* smem, int vb) {
  const int tid = tid_(), lane = tid & 63, wid = __builtin_amdgcn_readfirstlane(tid >> 6);
  const int wm = wid >> 1, wn = wid & 1, lr = lane & 31, lh = lane >> 5;
  const int nmt = g.T / 256;
  const u16* W = p.winT + (long)l * INWP * DM;
  const int ntiles = nmt * 43;
  for (int it = vb; it < ((ntiles + 7) & ~7); it += gridDim.x) {
    const int tt = xcd_tile(it, ntiles);
    if (tt < 0) continue;
    int nt, mt;
    tile_mn(tt, nmt, 43, mt, nt);
    int m0 = mt * 256, n0 = nt * 128;
    f32x16 acc[4][2];
    const u16* xb = (l == 0) ? g.xb : g.h1b;
    float rsd[4];
    gemm_main<true, false>([&](int kt) { return ASrc{xb + kt * 64, DM}; }, m0, W + (long)n0 * DM, DM, DM, smem, acc, 0.f, rsd);
    const int nw0 = n0 + wn * 64;
    if (nw0 >= INW) continue;
    if (l == 1) {
      const float* sq = p.rowsq + (size_t)4 * 50432 + g.seq0 + m0 + wm * 128 + lr;
#pragma unroll
      for (int mi = 0; mi < 4; ++mi) {
        const float r = __builtin_amdgcn_rsqf(sq[mi * 32] * (1.f / DM) + 1e-6f);
#pragma unroll
        for (int ni = 0; ni < 2; ++ni)
#pragma unroll
          for (int i = 0; i < 16; ++i) acc[mi][ni][i] *= r;
      }
    }
#pragma unroll
    for (int mi = 0; mi < 4; ++mi) {
      int m = m0 + wm * 128 + mi * 32 + lr;
      int b = m / g.Lp, t = m - b * g.Lp;
      if (nw0 == 1792) {
        rope_store(acc[mi][0], acc[mi][1], p.rope + t * 32, g.kr + (long)m * 64, lh);
      } else if (nw0 >= 2880 && nw0 < 3392) {
#pragma unroll
        for (int ni = 0; ni < 2; ++ni)
#pragma unroll
          for (int i = 0; i < 16; ++i) {
            const long uoff = (long)(nw0 - 2880 + ni * 32 + (i & 3) + 8 * (i >> 2)) * g.Lp * 2;
            const unsigned voff = (unsigned)(((b * 512 + 4 * lh) * g.Lp + t) * 2);
            *(u16*)((char*)g.vdt + uoff + voff) = bf1(acc[mi][ni][i]);
          }
      } else {
        u16* dst; int ld, base; bool sil = false;
        if (nw0 < 512) { dst = g.uf; ld = 512; base = 0; }
        else if (nw0 < 1280) { dst = g.cq; ld = 768; base = 512; }
        else if (nw0 < 1792) { dst = g.ckv; ld = 512; base = 1280; }
        else if (nw0 < 2368) { dst = g.qd; ld = 512; base = 1856; }
        else if (nw0 < 2880) { dst = g.kd; ld = 512; base = 2368; }
        else { dst = g.g; ld = 2048; base = 3392; sil = true; }
        if (nw0 >= 512 && nw0 < 1792) {
          float ss = 0.f;
#pragma unroll
          for (int ni = 0; ni < 2; ++ni)
#pragma unroll
            for (int i = 0; i < 16; ++i) ss += acc[mi][ni][i] * acc[mi][ni][i];
          atomicAdd(p.rowsq + (size_t)(l * 2 + (nw0 >= 1280 ? 1 : 0)) * 50432 + g.seq0 + m, ss);
        }
#pragma unroll
        for (int ni = 0; ni < 2; ++ni)
#pragma unroll
          for (int pr = 0; pr < 2; ++pr) {
            int n = nw0 - base + ni * 32 + 16 * pr;
            float v[8];
#pragma unroll
            for (int j = 0; j < 8; ++j) v[j] = acc[mi][ni][8 * pr + j];
            if (sil) {
#pragma unroll
              for (int j = 0; j < 8; ++j) v[j] = silu(v[j]);
            }
            store_bf8_pair(dst + (long)m * ld + n, lh, v[0], v[1], v[2], v[3], v[4], v[5], v[6], v[7]);
          }
      }
    }
  }
}

DI void phase_upproj(const Params& p, const GroupP& g, int l, char* smem, int vb) {
  const int tid = tid_(), lane = tid & 63, wid = __builtin_amdgcn_readfirstlane(tid >> 6);
  const int wm = wid >> 1, wn = wid & 1, lr = lane & 31, lh = lane >> 5;
  const int nmt = g.T / 256;
  u16* kn = g.xb;
  u16* vt = g.xb + (long)g.T * 1024;
  const int ntiles = nmt * 28;
  for (int it = vb; it < ((ntiles + 7) & ~7); it += gridDim.x) {
    const int tt = xcd_tile(it, ntiles);
    if (tt < 0) continue;
    int nt, mt;
    tile_mn(tt, nmt, 28, mt, nt);
    int m0 = mt * 256;
    f32x16 acc[4][2];
    float rs[4];
    if (nt < 28) {
      const bool isq = nt < 12;
      const int n0 = isq ? nt * 128 : (nt - 12) * 128;
      const u16* A = isq ? g.cq : g.ckv;
      const int Kd = isq ? 768 : 512;
      const u16* Bw = isq ? p.wuqT + (long)l * 1536 * 768 + (long)n0 * 768 : p.wukvT + (long)l * 2048 * 512 + (long)n0 * 512;
      gemm_main<true, false>([&](int kt) { return ASrc{A + kt * 64, (long)Kd}; }, m0, Bw, Kd, Kd, smem, acc, 0.f, rs);
      {
        const float* sq = p.rowsq + (size_t)(l * 2 + (isq ? 0 : 1)) * 50432 + g.seq0 + m0 + wm * 128 + lr;
        const float invK = 1.f / (float)Kd;
#pragma unroll
        for (int mi = 0; mi < 4; ++mi) rs[mi] = __builtin_amdgcn_rsqf(sq[mi * 32] * invK + 1e-6f);
      }
      const int nw0 = n0 + wn * 64;
      if (isq) {
        const int head = nw0 / 192, w = nw0 - head * 192;
#pragma unroll
        for (int mi = 0; mi < 4; ++mi) {
          int m = m0 + wm * 128 + mi * 32 + lr;
          float r = rs[mi];
          if (w == 128) {
            int b = m / g.Lp, t = m - b * g.Lp;
            f32x16 a0 = acc[mi][0], a1 = acc[mi][1];
#pragma unroll
            for (int i = 0; i < 16; ++i) { a0[i] *= r; a1[i] *= r; }
            rope_store(a0, a1, p.rope + t * 32, g.q + (long)m * 1536 + nw0, lh);
          } else {
            u16* qp = g.q + (long)m * 1536 + nw0;
#pragma unroll
            for (int ni = 0; ni < 2; ++ni)
#pragma unroll
              for (int pr = 0; pr < 2; ++pr)
                store_bf8_pair(qp + ni * 32 + 16 * pr, lh, acc[mi][ni][8 * pr] * r, acc[mi][ni][8 * pr + 1] * r,
                               acc[mi][ni][8 * pr + 2] * r, acc[mi][ni][8 * pr + 3] * r, acc[mi][ni][8 * pr + 4] * r,
                               acc[mi][ni][8 * pr + 5] * r, acc[mi][ni][8 * pr + 6] * r, acc[mi][ni][8 * pr + 7] * r);
          }
        }
      } else {
        const int head = n0 >> 8, isv = (n0 >> 7) & 1;
        if (!isv) {
#pragma unroll
          for (int mi = 0; mi < 4; ++mi) {
            int m = m0 + wm * 128 + mi * 32 + lr;
            float r = rs[mi];
            u16* kp = kn + (long)m * 1024 + head * 128 + wn * 64;
#pragma unroll
            for (int ni = 0; ni < 2; ++ni)
#pragma unroll
              for (int pr = 0; pr < 2; ++pr)
                store_bf8_pair(kp + ni * 32 + 16 * pr, lh, acc[mi][ni][8 * pr] * r, acc[mi][ni][8 * pr + 1] * r,
                               acc[mi][ni][8 * pr + 2] * r, acc[mi][ni][8 * pr + 3] * r, acc[mi][ni][8 * pr + 4] * r,
                               acc[mi][ni][8 * pr + 5] * r, acc[mi][ni][8 * pr + 6] * r, acc[mi][ni][8 * pr + 7] * r);
          }
        } else {
#pragma unroll
          for (int mi = 0; mi < 4; ++mi) {
            int m = m0 + wm * 128 + mi * 32 + lr;
            float r = rs[mi];
            int b = m / g.Lp, t = m - b * g.Lp;
            const unsigned voff = (unsigned)((((b * 8 + head) * 128 + 4 * lh) * g.Lp + t) * 2);
#pragma unroll
            for (int ni = 0; ni < 2; ++ni)
#pragma unroll
              for (int i = 0; i < 16; ++i) {
                const long uoff = (long)(wn * 64 + ni * 32 + (i & 3) + 8 * (i >> 2)) * g.Lp * 2;
                *(u16*)((char*)vt + uoff + voff) = bf1(acc[mi][ni][i] * r);
              }
          }
        }
      }
    }
  }
  {
    const int Hp = g.Hp, H = g.L >> 1, L = g.L, Lp = g.Lp;
    const int nft = (g.B * Hp) / 256;
    const int srow = tid >> 3, skc = tid & 7;
    char* sA = smem;
    char* sB = smem + 256 * 144;
    for (int it = vb; it < nft * 8; it += gridDim.x) {
      const int nt = it / nft, mt = it - nt * nft;
      const int m0 = mt * 256, n0 = nt * 128;
      const int gg = n0 >> 8, part = (n0 >> 7) & 1;
      const u16* Bw = p.mfT + (long)(l * 4 + gg) * 256 * 128 + (long)(n0 & 255) * 128;
      f32x16 acc[4][2];
#pragma unroll
      for (int mi = 0; mi < 4; ++mi)
#pragma unroll
        for (int ni = 0; ni < 2; ++ni)
#pragma unroll
          for (int i = 0; i < 16; ++i) acc[mi][ni][i] = 0.f;
      for (int kt = 0; kt < 2; ++kt) {
#pragma unroll
        for (int i = 0; i < 8; ++i) {
          const int row = srow + 32 * i;
          const int m = m0 + row;
          const int b = m / Hp, sidx = m - b * Hp;
          const bool pair = sidx >= 1 && sidx < H;
          const bool v1ok = (sidx <= H) && (pair || !part);
          u32x4 v1 = {0u, 0u, 0u, 0u}, v2 = {0u, 0u, 0u, 0u};
          if (v1ok) v1 = *(const u32x4*)(g.uf + ((long)(b * Lp + sidx)) * 512 + gg * 128 + kt * 64 + skc * 8);
          if (pair) v2 = *(const u32x4*)(g.uf + ((long)(b * Lp + L - sidx)) * 512 + gg * 128 + kt * 64 + skc * 8);
          u32x4 o;
#pragma unroll
          for (int j = 0; j < 4; ++j) {
            float a0 = bf_lo(v1[j]), a1 = bf_hi(v1[j]), b0 = bf_lo(v2[j]), b1 = bf_hi(v2[j]);
            o[j] = part ? pk2(a0 - b0, a1 - b1) : pk2(a0 + b0, a1 + b1);
          }
          *(u32x4*)(sA + row * 144 + skc * 16) = o;
        }
#pragma unroll
        for (int i = 0; i < 4; ++i)
          *(u32x4*)(sB + (srow + 32 * i) * 144 + skc * 16) = *(const u32x4*)(Bw + (long)(srow + 32 * i) * 128 + kt * 64 + skc * 8);
        __syncthreads();
#pragma unroll
        for (int ks = 0; ks < 4; ++ks) {
          bf16x8 af[4], bfr[2];
#pragma unroll
          for (int mi = 0; mi < 4; ++mi) af[mi] = *(const bf16x8*)(sA + (wm * 128 + mi * 32 + lr) * 144 + ks * 32 + lh * 16);
#pragma unroll
          for (int ni = 0; ni < 2; ++ni) bfr[ni] = *(const bf16x8*)(sB + (wn * 64 + ni * 32 + lr) * 144 + ks * 32 + lh * 16);
#pragma unroll
          for (int mi = 0; mi < 4; ++mi)
#pragma unroll
            for (int ni = 0; ni < 2; ++ni) acc[mi][ni] = MFMA(af[mi], bfr[ni], acc[mi][ni]);
        }
        __syncthreads();
      }
#pragma unroll
      for (int mi = 0; mi < 4; ++mi)
#pragma unroll
        for (int gi = 0; gi < 4; ++gi) {
          const int m = m0 + wm * 128 + mi * 32 + 8 * gi + 4 * lh;
          const int b = m / Hp, sidx = m - b * Hp;
#pragma unroll
          for (int ni = 0; ni < 2; ++ni) {
            const int d = wn * 64 + ni * 32 + lr;
            store_bf4(g.abt + ((long)(b * 512 + gg * 128 + d)) * (2 * Hp) + part * Hp + sidx, acc[mi][ni][4 * gi],
                      acc[mi][ni][4 * gi + 1], acc[mi][ni][4 * gi + 2], acc[mi][ni][4 * gi + 3]);
          }
        }
    }
  }
}

constexpr float SM_THR = 8.f;
DI void softmax_pv(f32x16 (&sa)[2], f32x16 (&O)[4], float& m, float& l, const char* sV, int lr, int lh, bool first) {
  float t0 = fmaxf(fmaxf(sa[0][0], sa[0][1]), sa[0][2]);
  float t1 = fmaxf(fmaxf(sa[1][0], sa[1][1]), sa[1][2]);
#pragma unroll
  for (int i = 3; i < 15; i += 2) {
    t0 = fmaxf(fmaxf(t0, sa[0][i]), sa[0][i + 1]);
    t1 = fmaxf(fmaxf(t1, sa[1][i]), sa[1][i + 1]);
  }
  float tmax = fmaxf(fmaxf(t0, t1), fmaxf(sa[0][15], sa[1][15]));
  tmax = fmaxf(tmax, __shfl_xor(tmax, 32, 64));
  if (first || __any(tmax > SM_THR)) {
    asm volatile("; rescale" ::: "memory");
    const float delta = first ? tmax : fmaxf(tmax, 0.f);
    const float alpha = __builtin_amdgcn_exp2f(-delta);
    m += delta;
    l *= alpha;
#pragma unroll
    for (int d = 0; d < 4; ++d)
#pragma unroll
      for (int i = 0; i < 16; ++i) O[d][i] *= alpha;
#pragma unroll
    for (int i = 0; i < 16; ++i) { sa[0][i] -= delta; sa[1][i] -= delta; }
  }
  float rsum0 = 0.f, rsum1 = 0.f;
#pragma unroll
  for (int i = 0; i < 16; ++i) {
    float p0 = __builtin_amdgcn_exp2f(sa[0][i]);
    float p1 = __builtin_amdgcn_exp2f(sa[1][i]);
    sa[0][i] = p0;
    sa[1][i] = p1;
    rsum0 += p0;
    rsum1 += p1;
  }
  l += rsum0 + rsum1;
  bf16x8 pf[4];
#pragma unroll
  for (int g4 = 0; g4 < 4; ++g4) {
    const int kb = g4 >> 1, s2 = g4 & 1;
    u32x4 pp;
#pragma unroll
    for (int j = 0; j < 4; ++j) pp[j] = pk2(sa[kb][8 * s2 + 2 * j], sa[kb][8 * s2 + 2 * j + 1]);
    pf[g4] = __builtin_bit_cast(bf16x8, pp);
  }
  const char* vrd = sV + lr * 144 + lh * 16;
  bf16x8 vfr[4];
#pragma unroll
  for (int t = 0; t < 3; ++t) vfr[t] = *(const bf16x8*)(vrd + (t & 3) * (32 * 144) + (t >> 2) * 32);
  __builtin_amdgcn_sched_group_barrier(0x100, 3, 0);
#pragma unroll
  for (int t = 0; t < 16; ++t) {
    if (t + 3 < 16) {
      vfr[(t + 3) & 3] = *(const bf16x8*)(vrd + ((t + 3) & 3) * (32 * 144) + ((t + 3) >> 2) * 32);
      __builtin_amdgcn_sched_group_barrier(0x100, 1, 0);
    }
    O[t & 3] = MFMA(vfr[t & 3], pf[t >> 2], O[t & 3]);
    __builtin_amdgcn_sched_group_barrier(0x008, 1, 0);
  }
}

DI void load_vtile(u32x4 (&rv)[4], const u16* __restrict__ vbase, int Lp, int key0, unsigned voffV) {
  const char* ub = (const char*)vbase + (long)key0 * 2;
#pragma unroll
  for (int i = 0; i < 4; ++i) rv[i] = *(const u32x4*)(ub + (long)(32 * i) * Lp * 2 + voffV);
}
DI void store_vtile(const u32x4 (&rv)[4], char* sVst) {
#pragma unroll
  for (int i = 0; i < 4; ++i) {
    u32x2 lo = {rv[i][0], rv[i][1]}, hi = {rv[i][2], rv[i][3]};
    *(u32x2*)(sVst + i * 4608) = lo;
    *(u32x2*)(sVst + i * 4608 + 16) = hi;
  }
}

DI void mla_item(const Params& p, const GroupP& g, int item, char* smem, bool dry) {
  const int tid = tid_(), lane = tid & 63, wid = __builtin_amdgcn_readfirstlane(tid >> 6), lr = lane & 31, lh = lane >> 5;
  const int nqb = g.Lp / 128;
  const int qb = item % nqb, bh = item / nqb, h = bh & 7, b = bh >> 3;
  const int Lp = g.Lp, L = g.L;
  char* sK = smem;
  char* sV = smem + 64 * 400;
  const u16* kn = g.xb + (long)b * Lp * 1024 + h * 128;
  const u16* kr = g.kr + (long)b * Lp * 64;
  const u16* vbase = g.xb + (long)g.T * 1024 + (long)(b * 8 + h) * 128 * Lp;
  const int qrow = b * Lp + qb * 128 + wid * 32 + lr;
  bf16x8 qf[12];
#pragma unroll
  for (int ks = 0; ks < 12; ++ks) qf[ks] = *(const bf16x8*)(g.q + (long)qrow * 1536 + h * 192 + ks * 16 + lh * 8);
  f32x16 O[4];
#pragma unroll
  for (int d = 0; d < 4; ++d)
#pragma unroll
    for (int i = 0; i < 16; ++i) O[d][i] = 0.f;
  float m = 0.f, l = 0.f;
  const int nkt = (L + 63) >> 6;
  u32x4 rk[6], rv[4];
  const unsigned voffKn = (unsigned)((tid >> 4) * 2048 + (tid & 15) * 16);
  const unsigned voffKr = (unsigned)((tid >> 3) * 128 + (tid & 7) * 16);
  const unsigned voffV = (unsigned)(((tid >> 3) * Lp + (tid & 7) * 8) * 2);
  char* sKn_st = sK + (tid >> 4) * 400 + (tid & 15) * 16;
  char* sKr_st = sK + (tid >> 3) * 400 + 256 + (tid & 7) * 16;
  char* sV_st = sV + (tid >> 3) * 144 + ((tid & 7) >> 1) * 32 + (tid & 1) * 8;
  auto loadK = [&](int kt) {
    const char* u1 = (const char*)kn + (long)kt * (64 * 2048);
#pragma unroll
    for (int i = 0; i < 4; ++i) rk[i] = *(const u32x4*)(u1 + i * (16 * 2048) + voffKn);
    const char* u2 = (const char*)kr + (long)kt * (64 * 128);
#pragma unroll
    for (int i = 0; i < 2; ++i) rk[4 + i] = *(const u32x4*)(u2 + i * (32 * 128) + voffKr);
  };
  auto storeK = [&]() {
#pragma unroll
    for (int i = 0; i < 4; ++i) *(u32x4*)(sKn_st + i * 6400) = rk[i];
#pragma unroll
    for (int i = 0; i < 2; ++i) *(u32x4*)(sKr_st + i * 12800) = rk[4 + i];
  };
  loadK(0);
  load_vtile(rv, vbase, Lp, 0, voffV);
  storeK();
  store_vtile(rv, sV_st);
  __syncthreads();
  for (int kt = 0; kt < nkt; ++kt) {
    const bool more = kt + 1 < nkt;
    if (more) loadK(kt + 1);
    __builtin_amdgcn_sched_barrier(0);
    f32x16 sa[2];
#pragma unroll
    for (int i = 0; i < 16; ++i) { sa[0][i] = -m; sa[1][i] = -m; }
    {
      const char* krd = sK + lr * 400 + lh * 16;
      bf16x8 kf[3][2];
#pragma unroll
      for (int q2 = 0; q2 < 2; ++q2) {
        kf[q2][0] = *(const bf16x8*)(krd + q2 * 32);
        kf[q2][1] = *(const bf16x8*)(krd + 32 * 400 + q2 * 32);
      }
      __builtin_amdgcn_sched_group_barrier(0x100, 4, 0);
#pragma unroll
      for (int ks = 0; ks < 12; ++ks) {
        if (ks + 2 < 12) {
          kf[(ks + 2) % 3][0] = *(const bf16x8*)(krd + (ks + 2) * 32);
          kf[(ks + 2) % 3][1] = *(const bf16x8*)(krd + 32 * 400 + (ks + 2) * 32);
          __builtin_amdgcn_sched_group_barrier(0x100, 2, 0);
        }
        sa[0] = MFMA(kf[ks % 3][0], qf[ks], sa[0]);
        sa[1] = MFMA(kf[ks % 3][1], qf[ks], sa[1]);
        __builtin_amdgcn_sched_group_barrier(0x008, 2, 0);
      }
    }
    if (kt == nkt - 1) {
      asm volatile("; masked tail tile" ::: "memory");
#pragma unroll
      for (int kb = 0; kb < 2; ++kb)
#pragma unroll
        for (int i = 0; i < 16; ++i)
          if (kt * 64 + kb * 32 + crow(i, lh) >= L) sa[kb][i] = -1e30f;
    }
    __syncthreads();
    if (more) { storeK(); load_vtile(rv, vbase, Lp, (kt + 1) * 64, voffV); }
    __builtin_amdgcn_sched_barrier(0);
    softmax_pv(sa, O, m, l, sV, lr, lh, kt == 0);
    __syncthreads();
    if (more) store_vtile(rv, sV_st);
  }
  float lt = l + __shfl_xor(l, 32, 64);
  float inv = 1.f / lt;
  const u16* gp = g.g + (long)qrow * 2048 + 512 + h * 128;
  u16* op = (dry ? (u16*)g.out : g.q) + (long)qrow * 1536 + h * 192;
#pragma unroll
  for (int d = 0; d < 4; ++d)
#pragma unroll
    for (int gi = 0; gi < 4; ++gi) {
      int dd = d * 32 + 8 * gi + 4 * lh;
      u32x2 gv = *(const u32x2*)(gp + dd);
      store_bf4(op + dd, O[d][4 * gi] * inv * bf_lo(gv[0]), O[d][4 * gi + 1] * inv * bf_hi(gv[0]),
                O[d][4 * gi + 2] * inv * bf_lo(gv[1]), O[d][4 * gi + 3] * inv * bf_hi(gv[1]));
    }
  __syncthreads();
}

DI int t5_bucket(int rel) {
  int n = rel < 0 ? -rel : rel;
  int bk;
  if (n < 8) bk = n;
  else if (n < 12) bk = 8;
  else if (n < 16) bk = 9;
  else if (n < 23) bk = 10;
  else if (n < 32) bk = 11;
  else if (n < 46) bk = 12;
  else if (n < 64) bk = 13;
  else if (n < 91) bk = 14;
  else bk = 15;
  return bk + (rel > 0 ? 16 : 0);
}

DI void diff_item(const Params& p, const GroupP& g, int l_layer, int item, char* smem, bool dry) {
  const int tid = tid_(), lane = tid & 63, wid = __builtin_amdgcn_readfirstlane(tid >> 6), lr = lane & 31, lh = lane >> 5;
  const int nqb = (g.L + 63) / 64;
  const int qb = item % nqb, bh = item / nqb, h = bh & 3, b = bh >> 2;
  const int Lp = g.Lp, L = g.L;
  const int map = wid >> 1, qs = wid & 1;
  char* sK = smem;
  char* sV = smem + 64 * 272;
  float* sBias = (float*)(smem + 64 * 272 + 128 * 144);
  float* o2buf = (float*)smem;
  const u16* kd = g.kd + (long)b * Lp * 512 + h * 128;
  const u16* vbase = g.vdt + (long)(b * 4 + h) * 128 * Lp;
  const int qpos = qb * 64 + qs * 32 + lr;
  const long qrow = (long)b * Lp + qpos;
  for (int i = tid; i < 257; i += NTHR) sBias[i] = p.rel_bias[t5_bucket(i - 128) * 4 + h] * LOG2E;
  const float bneg = p.rel_bias[15 * 4 + h] * LOG2E, bpos = p.rel_bias[31 * 4 + h] * LOG2E;
  bf16x8 qf[4];
#pragma unroll
  for (int ks = 0; ks < 4; ++ks) qf[ks] = *(const bf16x8*)(g.qd + qrow * 512 + h * 128 + map * 64 + ks * 16 + lh * 8);
  f32x16 O[4];
#pragma unroll
  for (int d = 0; d < 4; ++d)
#pragma unroll
    for (int i = 0; i < 16; ++i) O[d][i] = 0.f;
  float m = 0.f, l = 0.f;
  const int nkt = (L + 63) >> 6;
  u32x4 rk[4], rv[4];
  const unsigned voffK = (unsigned)((tid >> 4) * 1024 + (tid & 15) * 16);
  const unsigned voffV = (unsigned)(((tid >> 3) * Lp + (tid & 7) * 8) * 2);
  char* sK_st = sK + (tid >> 4) * 272 + (tid & 15) * 16;
  char* sV_st = sV + (tid >> 3) * 144 + ((tid & 7) >> 1) * 32 + (tid & 1) * 8;
  auto loadK = [&](int kt) {
    const char* u1 = (const char*)kd + (long)kt * (64 * 1024);
#pragma unroll
    for (int i = 0; i < 4; ++i) rk[i] = *(const u32x4*)(u1 + i * (16 * 1024) + voffK);
  };
  auto storeK = [&]() {
#pragma unroll
    for (int i = 0; i < 4; ++i) *(u32x4*)(sK_st + i * (16 * 272)) = rk[i];
  };
  const int qw0 = qb * 64 + qs * 32;
  loadK(0);
  load_vtile(rv, vbase, Lp, 0, voffV);
  storeK();
  store_vtile(rv, sV_st);
  __syncthreads();
  for (int kt = 0; kt < nkt; ++kt) {
    const bool more = kt + 1 < nkt;
    if (more) loadK(kt + 1);
    __builtin_amdgcn_sched_barrier(0);
    const int key0 = kt * 64;
    const int relmin = key0 - (qw0 + 31), relmax = key0 + 63 - qw0;
    const bool farp = relmin >= 128, farn = relmax <= -128;
    const float binit = (farp ? bpos : (farn ? bneg : 0.f)) - m;
    f32x16 sa[2];
#pragma unroll
    for (int i = 0; i < 16; ++i) { sa[0][i] = binit; sa[1][i] = binit; }
    {
      const char* krd = sK + lr * 272 + map * 128 + lh * 16;
      bf16x8 kf[4][2];
#pragma unroll
      for (int ks = 0; ks < 4; ++ks) {
        kf[ks][0] = *(const bf16x8*)(krd + ks * 32);
        kf[ks][1] = *(const bf16x8*)(krd + 32 * 272 + ks * 32);
      }
#pragma unroll
      for (int ks = 0; ks < 4; ++ks) {
        sa[0] = MFMA(kf[ks][0], qf[ks], sa[0]);
        sa[1] = MFMA(kf[ks][1], qf[ks], sa[1]);
      }
    }
    if (!farp && !farn) {
      asm volatile("; near-diagonal bias tile" ::: "memory");
#pragma unroll
      for (int kb = 0; kb < 2; ++kb)
#pragma unroll
        for (int i = 0; i < 16; ++i) {
          int rel = key0 + kb * 32 + crow(i, lh) - qpos;
          rel = rel < -128 ? -128 : (rel > 128 ? 128 : rel);
          sa[kb][i] += sBias[rel + 128];
        }
    }
    if (kt == nkt - 1) {
      asm volatile("; masked tail tile" ::: "memory");
#pragma unroll
      for (int kb = 0; kb < 2; ++kb)
#pragma unroll
        for (int i = 0; i < 16; ++i)
          if (key0 + kb * 32 + crow(i, lh) >= L) sa[kb][i] = -1e30f;
    }
    __syncthreads();
    if (more) { storeK(); load_vtile(rv, vbase, Lp, (kt + 1) * 64, voffV); }
    __builtin_amdgcn_sched_barrier(0);
    softmax_pv(sa, O, m, l, sV, lr, lh, kt == 0);
    __syncthreads();
    if (more) store_vtile(rv, sV_st);
  }
  float lt = l + __shfl_xor(l, 32, 64);
  float inv = 1.f / lt;
  if (map == 1) {
#pragma unroll
    for (int d = 0; d < 4; ++d)
#pragma unroll
      for (int i = 0; i < 16; ++i) o2buf[(d * 32 + crow(i, lh)) * 64 + qs * 32 + lr] = O[d][i] * inv;
  }
  __syncthreads();
  if (map == 0) {
    const float lam = p.lam[l_layer];
    const float lam_init = l_layer ? 0.35550906759f : 0.2f;
    float ss = 0.f;
#pragma unroll
    for (int d = 0; d < 4; ++d)
#pragma unroll
      for (int i = 0; i < 16; ++i) {
        float o = O[d][i] * inv - lam * o2buf[(d * 32 + crow(i, lh)) * 64 + qs * 32 + lr];
        O[d][i] = o;
        ss += o * o;
      }
    ss += __shfl_xor(ss, 32, 64);
    float r = __builtin_amdgcn_rsqf(ss * (1.f / 128.f) + 1e-5f) * (1.f - lam_init);
    const u16* gp = g.g + qrow * 2048 + 1536 + h * 128;
    const float* dn = p.diff_norm + l_layer * 128;
    u16* op = (dry ? (u16*)g.out + (long)g.T * 1536 : g.qd) + qrow * 512 + h * 128;
#pragma unroll
    for (int d = 0; d < 4; ++d)
#pragma unroll
      for (int gi = 0; gi < 4; ++gi) {
        int dd = d * 32 + 8 * gi + 4 * lh;
        u32x2 gv = *(const u32x2*)(gp + dd);
        float4 w = *(const float4*)(dn + dd);
        store_bf4(op + dd, O[d][4 * gi] * r * w.x * bf_lo(gv[0]), O[d][4 * gi + 1] * r * w.y * bf_hi(gv[0]),
                  O[d][4 * gi + 2] * r * w.z * bf_lo(gv[1]), O[d][4 * gi + 3] * r * w.w * bf_hi(gv[1]));
      }
  }
  __syncthreads();
}

DI float* dft_part(const GroupP& g, int part) { return (float*)g.cq + (size_t)part * g.B * g.Hp * 512; }
DI void dft_item(const Params& p, const GroupP& g, int item, char* smem) {
  const int tid = tid_(), lane = tid & 63, wid = __builtin_amdgcn_readfirstlane(tid >> 6);
  const int wm = wid >> 1, wn = wid & 1, lr = lane & 31, lh = lane >> 5;
  const int nb8 = g.B * 8;
  int mt = item / nb8, r = item - mt * nb8;
  int b = r >> 3, nt = (r >> 1) & 3, part = r & 1;
  int m0 = mt * 256, n0 = nt * 128;
  const int Hp = g.Hp, K2 = 2 * Hp;
  f32x16 acc[4][2];
  const u16* A = g.fm + part * Hp;
  float rsd[4];
  gemm_main<true, false>([&](int kt) { return ASrc{A + kt * 64, (long)K2}; }, m0, g.abt + ((long)b * 512 + n0) * K2 + part * Hp, K2, Hp, smem, acc, 0.f, rsd);
  float* dst = dft_part(g, part) + (size_t)b * Hp * 512;
#pragma unroll
  for (int mi = 0; mi < 4; ++mi) {
    int mm = m0 + wm * 128 + mi * 32 + lr;
    if (mm >= Hp) continue;
#pragma unroll
    for (int ni = 0; ni < 2; ++ni)
#pragma unroll
      for (int gi = 0; gi < 4; ++gi) {
        int n = n0 + wn * 64 + ni * 32 + 8 * gi + 4 * lh;
        float4 o = {acc[mi][ni][4 * gi], acc[mi][ni][4 * gi + 1], acc[mi][ni][4 * gi + 2], acc[mi][ni][4 * gi + 3]};
        *(float4*)(dst + (size_t)mm * 512 + n) = o;
      }
  }
}

DI void phase_dftfin(const GroupP& g, int vb) {
  const int tid = tid_();
  const int H = g.L >> 1, Hp = g.Hp, L = g.L, Lp = g.Lp;
  const float* P = dft_part(g, 0);
  const float* Q = dft_part(g, 1);
  const int total = g.B * (H + 1) * 128;
  for (int i = vb * NTHR + tid; i < total; i += gridDim.x * NTHR) {
    const int c = i & 127, rk = i >> 7;
    const int b = rk / (H + 1), k = rk - b * (H + 1);
    const size_t src = ((size_t)b * Hp + k) * 512 + c * 4;
    const float4 pv = *(const float4*)(P + src);
    const float4 qv = *(const float4*)(Q + src);
    const long row1 = (long)b * Lp + k;
    const u32x2 g1 = *(const u32x2*)(g.g + row1 * 2048 + c * 4);
    store_bf4(g.uf + row1 * 512 + c * 4, (pv.x + qv.x) * bf_lo(g1[0]), (pv.y + qv.y) * bf_hi(g1[0]), (pv.z + qv.z) * bf_lo(g1[1]),
              (pv.w + qv.w) * bf_hi(g1[1]));
    if (k >= 1 && k < H) {
      const long row2 = (long)b * Lp + (L - k);
      const u32x2 g2 = *(const u32x2*)(g.g + row2 * 2048 + c * 4);
      store_bf4(g.uf + row2 * 512 + c * 4, (pv.x - qv.x) * bf_lo(g2[0]), (pv.y - qv.y) * bf_hi(g2[0]), (pv.z - qv.z) * bf_lo(g2[1]),
                (pv.w - qv.w) * bf_hi(g2[1]));
    }
  }
}

DI int pad8(int n) { return (n + 7) & ~7; }

DI void phase_mix(const Params& p, int l, char* smem, int xcc) {
  const GroupP& ga = p.grp[0];
  const GroupP& gb = p.grp[1];
  int* s_item = (int*)(smem + SMEM_BYTES - 16);
  const int G = gridDim.x;
  {
    const int nDft1 = gb.B * ((gb.Hp + 255) / 256) * 8;
    const int nDft0 = ga.B * ((ga.Hp + 255) / 256) * 8;
    for (int it = blockIdx.x; it < pad8(nDft1); it += G) {
      const int tt = xcd_tile(it, nDft1);
      if (tt >= 0) dft_item(p, gb, tt, smem);
    }
    const int vb = (blockIdx.x + G - pad8(nDft1) % G) % G;
    for (int it = vb; it < pad8(nDft0); it += G) {
      const int tt = xcd_tile(it, nDft0);
      if (tt >= 0) dft_item(p, ga, tt, smem);
    }
  }
  const int nqbMa = ga.Lp / 128, nqbDa = (ga.L + 63) / 64, nqbMb = gb.Lp / 128, nqbDb = (gb.L + 63) / 64;
  const int nMa = ga.B * nqbMa, nDa = (ga.B >> 1) * nqbDa;
  const int nMb = gb.B * nqbMb, nDb = (gb.B >> 1) * nqbDb;
  const int e0 = nMa, e1 = e0 + nDa, e2 = e1 + nMb, perX = e2 + nDb;
  int* ctrb = p.ctr + l * 8;
  for (int steal = 0; steal < 8; ++steal) {
    const int q = (xcc + steal) & 7;
    for (;;) {
      if (threadIdx.x == 0) *s_item = atomicAdd(&ctrb[q], 1);
      __syncthreads();
      const int j = *s_item;
      __syncthreads();
      if (j >= perX) break;
      if (j < e0) {
        const int pl = j / nqbMa, qb = j - pl * nqbMa;
        mla_item(p, ga, (q + 8 * pl) * nqbMa + qb, smem, false);
      } else if (j < e1) {
        const int jj = j - e0;
        const int pl = jj / nqbDa, qb = jj - pl * nqbDa;
        diff_item(p, ga, l, (q + 8 * pl) * nqbDa + qb, smem, false);
      } else if (j < e2) {
        const int jj = j - e1;
        const int pl = jj / nqbMb, qb = jj - pl * nqbMb;
        mla_item(p, gb, (q + 8 * pl) * nqbMb + qb, smem, false);
      } else {
        const int jj = j - e2;
        const int pl = jj / nqbDb, qb = jj - pl * nqbDb;
        diff_item(p, gb, l, (q + 8 * pl) * nqbDb + qb, smem, false);
      }
    }
  }
}

DI void phase_outproj(const Params& p, const GroupP& g, int l, char* smem, int vb) {
  const int tid = tid_(), lane = tid & 63, wid = __builtin_amdgcn_readfirstlane(tid >> 6);
  const int wm = wid >> 1, wn = wid & 1, lr = lane & 31, lh = lane >> 5;
  const int nmt = g.T / 256;
  const u16* W = p.woT + (long)l * DM * DM;
  const int ntiles = nmt * 16;
  for (int it = vb; it < ((ntiles + 7) & ~7); it += gridDim.x) {
    const int tt = xcd_tile(it, ntiles);
    if (tt < 0) continue;
    int nt, mt;
    tile_mn(tt, nmt, 16, mt, nt);
    int m0 = mt * 256, n0 = nt * 128;
    f32x16 acc[4][2];
    const u16 *uf = g.uf, *q = g.q, *qd = g.qd;
    float rsd[4];
    gemm_main<true, false>(
        [&](int kt) {
          int k0 = kt * 64;
          if (k0 < 512) return ASrc{uf + k0, 512};
          if (k0 < 1536) { int kk = k0 - 512; return ASrc{q + (kk >> 7) * 192 + (kk & 127), 1536}; }
          return ASrc{qd + (k0 - 1536), 512};
        },
        m0, W + (long)n0 * DM, DM, DM, smem, acc, 0.f, rsd);
#pragma unroll
    for (int mi = 0; mi < 4; ++mi) {
      int m = m0 + wm * 128 + mi * 32 + lr;
      int b = m / g.Lp, t = m - b * g.Lp;
      if (t >= g.L) continue;
      if (l == 0) {
        const float* res = (t < 16) ? p.meta + t * DM : g.x + ((long)b * (g.L - 16) + (t - 16)) * DM;
        u16* dst = g.h1b + (long)m * DM;
        float ss = 0.f;
#pragma unroll
        for (int ni = 0; ni < 2; ++ni)
#pragma unroll
          for (int gi = 0; gi < 4; ++gi) {
            int n = n0 + wn * 64 + ni * 32 + 8 * gi + 4 * lh;
            float4 rv = *(const float4*)(res + n);
            const float a0 = rv.x + acc[mi][ni][4 * gi], a1 = rv.y + acc[mi][ni][4 * gi + 1];
            const float a2 = rv.z + acc[mi][ni][4 * gi + 2], a3 = rv.w + acc[mi][ni][4 * gi + 3];
            store_bf4(dst + n, a0, a1, a2, a3);
            ss += a0 * a0 + a1 * a1 + a2 * a2 + a3 * a3;
          }
        atomicAdd(p.rowsq + (size_t)4 * 50432 + g.seq0 + m, ss);
      } else {
        if (t < 16) continue;
        const u16* res = g.h1b + (long)m * DM;
        float* dst = g.out + ((long)b * (g.L - 16) + (t - 16)) * DM;
#pragma unroll
        for (int ni = 0; ni < 2; ++ni)
#pragma unroll
          for (int gi = 0; gi < 4; ++gi) {
            int n = n0 + wn * 64 + ni * 32 + 8 * gi + 4 * lh;
            u32x2 rv = *(const u32x2*)(res + n);
            float4 o = {bf_lo(rv[0]) + acc[mi][ni][4 * gi], bf_hi(rv[0]) + acc[mi][ni][4 * gi + 1],
                        bf_lo(rv[1]) + acc[mi][ni][4 * gi + 2], bf_hi(rv[1]) + acc[mi][ni][4 * gi + 3]};
            *(float4*)(dst + n) = o;
          }
      }
    }
  }
}

DI void phase_final(const Params& p) {
  const int tid = tid_(), lane = tid & 63, wid = __builtin_amdgcn_readfirstlane(tid >> 6);
  const int rows0 = p.grp[0].B * (p.grp[0].L - 16), rows1 = p.grp[1].B * (p.grp[1].L - 16);
  for (int it = blockIdx.x; it < (rows0 + rows1) / 4; it += gridDim.x) {
    int row = it * 4 + wid;
    float* ptr = (row < rows0) ? p.grp[0].out + (long)row * DM : p.grp[1].out + (long)(row - rows0) * DM;
    float4 v[8];
    float ss = 0.f;
#pragma unroll
    for (int i = 0; i < 8; ++i) {
      v[i] = *(const float4*)(ptr + (i * 64 + lane) * 4);
      ss += v[i].x * v[i].x + v[i].y * v[i].y + v[i].z * v[i].z + v[i].w * v[i].w;
    }
    ss = wave_sum(ss);
    float r = __builtin_amdgcn_rsqf(ss * (1.f / DM) + 1e-6f);
#pragma unroll
    for (int i = 0; i < 8; ++i) {
      float4 w = *(const float4*)(p.final_norm + (i * 64 + lane) * 4);
      float4 o = {v[i].x * r * w.x, v[i].y * r * w.y, v[i].z * r * w.z, v[i].w * r * w.w};
      *(float4*)(ptr + (i * 64 + lane) * 4) = o;
    }
  }
}

#define XB_TMO      128
#define XB_XCNT(j)  (256  + 64 * (j))
#define XB_XSUB(j)  (1280 + 64 * (j))
#define XB_XGEN(j)  (2304 + 64 * (j))
#define XB_TOP      3328
#define XB_TOPGEN   3392
#define XCD_BAR_WORDS 3456
#define XB_SPIN_CAP (1u << 22)
#define LAS __attribute__((address_space(3)))
DI unsigned xb_ld(unsigned* p) { return __hip_atomic_load(p, __ATOMIC_RELAXED, __HIP_MEMORY_SCOPE_AGENT); }
DI unsigned xb_add(unsigned* p, unsigned v) { return __hip_atomic_fetch_add(p, v, __ATOMIC_RELAXED, __HIP_MEMORY_SCOPE_AGENT); }
DI unsigned xb_xcc_id() { return (unsigned)__builtin_amdgcn_s_getreg((3 << 11) | 20) & 0xFu; }
#define XB_SPIN(cond, bar) do { unsigned _sp = 0; while (cond) { __builtin_amdgcn_s_sleep(1); \
    if ((++_sp & 255u) == 0u) { if (xb_ld(&(bar)[XB_TMO])) break; if (_sp > XB_SPIN_CAP) { atomicAdd(&(bar)[XB_TMO], 1u); break; } } } } while (0)
struct XcdBarrier { unsigned* bar; unsigned x; volatile LAS unsigned* st; };
DI XcdBarrier xcd_barrier_post(unsigned* bar, volatile LAS unsigned* st) {
  XcdBarrier b; b.bar = bar; b.x = xb_xcc_id(); b.st = st;
  if (threadIdx.x == 0) (void)xb_add(&bar[XB_XCNT(b.x)], 1u);
  return b;
}
DI void xcd_barrier_complete(unsigned* bar, unsigned x, unsigned& nloc, unsigned& nx) {
  const unsigned G = gridDim.x * gridDim.y * gridDim.z;
  unsigned sum, cnt, mine, sp = 0u;
  for (;;) {
    sum = 0u; cnt = 0u; mine = 0u;
#pragma unroll
    for (unsigned j = 0; j < 16; ++j) { const unsigned c = xb_ld(&bar[XB_XCNT(j)]); sum += c; cnt += (c > 0u) ? 1u : 0u; mine = (j == x) ? c : mine; }
    if (sum == G) break;
    __builtin_amdgcn_s_sleep(1);
    if ((++sp & 255u) == 0u) { if (xb_ld(&bar[XB_TMO])) break; if (sp > XB_SPIN_CAP) { atomicAdd(&bar[XB_TMO], 1u); break; } }
  }
  nloc = mine > 0u ? mine : 1u; nx = cnt > 0u ? cnt : 1u;
}
DI void xcd_barrier(const XcdBarrier& b) {
  asm volatile("s_waitcnt vmcnt(0)" ::: "memory");
  __syncthreads();
  if (threadIdx.x == 0) {
    unsigned* bar = b.bar;
    __builtin_amdgcn_s_waitcnt(0);
    unsigned nloc = b.st[0], nx = b.st[1];
    if (nloc == 0u) { xcd_barrier_complete(bar, b.x, nloc, nx); b.st[0] = nloc; b.st[1] = nx; }
    const unsigned old = xb_add(&bar[XB_XSUB(b.x)], 1u);
    const unsigned gen = old / nloc;
    if (old + 1u == (gen + 1u) * nloc) {
      __builtin_amdgcn_fence(__ATOMIC_RELEASE, "agent");
      asm volatile("s_waitcnt vmcnt(0)" ::: "memory");
      const unsigned og = xb_add(&bar[XB_TOP], 1u);
      const unsigned tg = og / nx;
      if (og + 1u == (tg + 1u) * nx) xb_add(&bar[XB_TOPGEN], 1u);
      else XB_SPIN(xb_ld(&bar[XB_TOPGEN]) == tg, bar);
      __builtin_amdgcn_fence(__ATOMIC_ACQUIRE, "agent");
      xb_add(&bar[XB_XGEN(b.x)], 1u);
      asm volatile("s_waitcnt vmcnt(0)" ::: "memory");
    } else {
      XB_SPIN(xb_ld(&bar[XB_XGEN(b.x)]) == gen, bar);
      __builtin_amdgcn_fence(__ATOMIC_ACQUIRE, "agent");
      asm volatile("s_waitcnt vmcnt(0)" ::: "memory");
    }
  }
  __syncthreads();
}

constexpr int NPHASE = 12;

__global__ void __launch_bounds__(NTHR, 2) mega(Params p_unused, int ph_lo, int ph_hi) {
  __shared__ __attribute__((aligned(16))) char smem[SMEM_BYTES];
  __shared__ uint4 xb_words;
  if (threadIdx.x == 0) xb_words = make_uint4(0u, 0u, 0u, 0u);
  __syncthreads();
  {
    typedef const __attribute__((address_space(4))) Params* CPP0;
    CPP0 kp0 = (CPP0)__builtin_amdgcn_kernarg_segment_ptr();
    (void)xcd_barrier_post(kp0->bar, (volatile LAS unsigned*)&xb_words);
  }
  for (int ph = ph_lo; ph < ph_hi; ++ph) {
    typedef const __attribute__((address_space(4))) char* CP;
    CP kq = (CP)__builtin_amdgcn_kernarg_segment_ptr();
    asm volatile("" : "+s"(kq));
    typedef const __attribute__((address_space(4))) Params* CPP;
    CPP kp = (CPP)kq;
    Params p;
    p.grp[0].x = kp->grp[0].x;
    p.grp[0].out = kp->grp[0].out;
    p.grp[0].B = kp->grp[0].B;
    p.grp[0].L = kp->grp[0].L;
    p.grp[0].Lp = kp->grp[0].Lp;
    p.grp[0].T = kp->grp[0].T;
    p.grp[0].seq0 = kp->grp[0].seq0;
    p.grp[0].Hp = kp->grp[0].Hp;
    p.grp[0].xb = kp->grp[0].xb;
    p.grp[0].uf = kp->grp[0].uf;
    p.grp[0].cq = kp->grp[0].cq;
    p.grp[0].ckv = kp->grp[0].ckv;
    p.grp[0].kr = kp->grp[0].kr;
    p.grp[0].qd = kp->grp[0].qd;
    p.grp[0].kd = kp->grp[0].kd;
    p.grp[0].vdt = kp->grp[0].vdt;
    p.grp[0].g = kp->grp[0].g;
    p.grp[0].q = kp->grp[0].q;
    p.grp[0].abt = kp->grp[0].abt;
    p.grp[0].fm = kp->grp[0].fm;
    p.grp[0].h1b = kp->grp[0].h1b;
    p.grp[1].x = kp->grp[1].x;
    p.grp[1].out = kp->grp[1].out;
    p.grp[1].B = kp->grp[1].B;
    p.grp[1].L = kp->grp[1].L;
    p.grp[1].Lp = kp->grp[1].Lp;
    p.grp[1].T = kp->grp[1].T;
    p.grp[1].seq0 = kp->grp[1].seq0;
    p.grp[1].Hp = kp->grp[1].Hp;
    p.grp[1].xb = kp->grp[1].xb;
    p.grp[1].uf = kp->grp[1].uf;
    p.grp[1].cq = kp->grp[1].cq;
    p.grp[1].ckv = kp->grp[1].ckv;
    p.grp[1].kr = kp->grp[1].kr;
    p.grp[1].qd = kp->grp[1].qd;
    p.grp[1].kd = kp->grp[1].kd;
    p.grp[1].vdt = kp->grp[1].vdt;
    p.grp[1].g = kp->grp[1].g;
    p.grp[1].q = kp->grp[1].q;
    p.grp[1].abt = kp->grp[1].abt;
    p.grp[1].fm = kp->grp[1].fm;
    p.grp[1].h1b = kp->grp[1].h1b;
    p.meta = kp->meta;
    p.rel_bias = kp->rel_bias;
    p.final_norm = kp->final_norm;
    p.norm_w = kp->norm_w;
    p.w_in = kp->w_in;
    p.w_fmix = kp->w_fmix;
    p.q_norm = kp->q_norm;
    p.w_uq = kp->w_uq;
    p.kv_norm = kp->kv_norm;
    p.w_ukv = kp->w_ukv;
    p.lq1 = kp->lq1;
    p.lk1 = kp->lk1;
    p.lq2 = kp->lq2;
    p.lk2 = kp->lk2;
    p.diff_norm = kp->diff_norm;
    p.w_o = kp->w_o;
    p.winT = kp->winT;
    p.wuqT = kp->wuqT;
    p.wukvT = kp->wukvT;
    p.woT = kp->woT;
    p.mfT = kp->mfT;
    p.rope = kp->rope;
    p.lam = kp->lam;
    p.hmeta = kp->hmeta;
    p.ctr = kp->ctr;
    p.bar = kp->bar;
    p.rowsq = kp->rowsq;
    if (ph == 11) {
      phase_final(p);
    } else {
      const int l = ph >= 6 ? 1 : 0, st = ph >= 6 ? ph - 5 : ph;
      const GroupP& g0 = p.grp[0];
      const GroupP& g1 = p.grp[1];
      const int G = gridDim.x, bid = blockIdx.x;
      if (st == 0) {
        if (ph == 0) phase_wprep(p, &kp->rope_hi[0], &kp->rope_lo[0], smem, 0);
        phase_rowprep(p, g1, l, bid);
        phase_rowprep(p, g0, l, (bid + G - (g1.T / 4) % G) % G);
      } else if (st == 1) {
        phase_inproj(p, g1, l, smem, bid);
        phase_inproj(p, g0, l, smem, (bid + G - pad8((g1.T / 256) * 43) % G) % G);
        if (l == 0) {
          phase_wprep(p, &kp->rope_hi[0], &kp->rope_lo[0], smem, 1);
          phase_dftfill(g1, G - 1 - bid);
          phase_dftfill(g0, G - 1 - bid);
        }
      } else if (st == 2) {
        phase_upproj(p, g1, l, smem, bid);
        phase_upproj(p, g0, l, smem, (bid + G - pad8((g1.T / 256) * 28) % G) % G);
      } else if (st == 3) {
        phase_mix(p, l, smem, (int)(xb_xcc_id() & 7u));
      } else if (st == 4) {
        phase_dftfin(g1, bid);
        phase_dftfin(g0, bid);
      } else {
        phase_outproj(p, g1, l, smem, bid);
        phase_outproj(p, g0, l, smem, (bid + G - pad8((g1.T / 256) * 16) % G) % G);
      }
    }
    if (ph + 1 < ph_hi) {
      XcdBarrier xb;
      xb.bar = p.bar; xb.x = xb_xcc_id(); xb.st = (volatile LAS unsigned*)&xb_words;
      xcd_barrier(xb);
    }
    if (ph_hi == 0x7fffffff) cg::this_grid().sync();
  }
}

extern "C" void kernel_launch(void* const* d_in, const int* in_sizes, int n_in, void* d_out, int out_size, void* d_ws,
                              size_t ws_size, hipStream_t stream) {
  Params p;
  memset(&p, 0, sizeof(p));
  const float* x_prompt = (const float*)d_in[0];
  const float* x_sample = (const float*)d_in[1];
  p.meta = (const float*)d_in[2];
  p.rel_bias = (const float*)d_in[3];
  p.final_norm = (const float*)d_in[4];
  p.norm_w = (const float*)d_in[5];
  p.w_in = (const float*)d_in[6];
  p.w_fmix = (const float*)d_in[7];
  p.q_norm = (const float*)d_in[8];
  p.w_uq = (const float*)d_in[9];
  p.kv_norm = (const float*)d_in[10];
  p.w_ukv = (const float*)d_in[11];
  p.lq1 = (const float*)d_in[12];
  p.lk1 = (const float*)d_in[13];
  p.lq2 = (const float*)d_in[14];
  p.lk2 = (const float*)d_in[15];
  p.diff_norm = (const float*)d_in[16];
  p.w_o = (const float*)d_in[17];

  for (int c = 0; c < 32; ++c) {
    double inv = pow(10000.0, -(double)c / 32.0) / (2.0 * 3.14159265358979323846);
    float hi = (float)inv;
    p.rope_hi[c] = hi;
    p.rope_lo[c] = (float)(inv - (double)hi);
  }
  char* ws = (char*)d_ws;
  size_t off = 0;
  auto take = [&](size_t bytes) { char* r = ws + off; off += (bytes + 255) & ~(size_t)255; return r; };
  p.winT = (u16*)take((size_t)2 * INWP * DM * 2);
  p.wuqT = (u16*)take((size_t)2 * 1536 * 768 * 2);
  p.wukvT = (u16*)take((size_t)2 * 2048 * 512 * 2);
  p.woT = (u16*)take((size_t)2 * DM * DM * 2);
  p.mfT = (u16*)take((size_t)2 * 4 * 256 * 128 * 2);
  p.rope = (float2*)take((size_t)8320 * 32 * 8);
  p.lam = (float*)take(256);
  p.hmeta = (float*)take((size_t)10 * 16 * DM * 4);
  p.ctr = (int*)take(1024);
  p.bar = (unsigned*)take(XCD_BAR_WORDS * 4);
  p.rowsq = (float*)take((size_t)5 * 50432 * 4);
  char* os = (char*)d_out;
  size_t ooff = 0;
  auto otake = [&](size_t bytes) { char* r = os + ooff; ooff += (bytes + 255) & ~(size_t)255; return r; };
  for (int gi = 0; gi < 2; ++gi) {
    GroupP& g = p.grp[gi];
    g.B = gi == 0 ? 2 : 8;
    int S = gi == 0 ? 8192 : 4096;
    g.L = S + 16;
    g.Lp = (g.L + 127) / 128 * 128;
    g.T = g.B * g.Lp;
    g.Hp = (g.L / 2 + 1 + 127) / 128 * 128;
    g.seq0 = gi == 0 ? 0 : 16640;
    g.x = gi == 0 ? x_prompt : x_sample;
    g.out = (float*)d_out + (gi == 0 ? 0 : (size_t)2 * 8192 * DM);
    size_t T = g.T;
    g.xb = (u16*)otake(T * 2048 * 2);
    g.cq = (u16*)otake(T * 768 * 2);
    g.ckv = (u16*)otake(T * 512 * 2);
    g.kr = (u16*)otake(T * 64 * 2);
    g.kd = (u16*)otake(T * 512 * 2);
    g.uf = (u16*)take(T * 512 * 2);
    g.qd = (u16*)take(T * 512 * 2);
    g.vdt = (u16*)take(T * 512 * 2);
    g.g = (u16*)take(T * 2048 * 2);
    g.q = (u16*)take(T * 1536 * 2);
    g.h1b = (u16*)take(T * 2048 * 2);
    g.abt = (u16*)take((size_t)g.B * 512 * 2 * g.Hp * 2);
    g.fm = (u16*)take((size_t)((g.Hp + 255) / 256 * 256) * 2 * g.Hp * 2);
  }
  const size_t need = off;
  if (need > ws_size || ooff > (size_t)out_size * 4) {
    fprintf(stderr, "workspace too small: need %zu have %zu (out scratch %zu of %zu)\n", need, ws_size, ooff, (size_t)out_size * 4);
    return;
  }

  static int grid_blocks = 0;
  if (!grid_blocks) {
    int dev = 0, cus = 0, per_cu = 0;
    hipGetDevice(&dev);
    hipDeviceGetAttribute(&cus, hipDeviceAttributeMultiprocessorCount, dev);
    hipOccupancyMaxActiveBlocksPerMultiprocessor(&per_cu, mega, NTHR, 0);
    if (per_cu < 1) per_cu = 1;
    if (per_cu > 2) per_cu = 2;
    grid_blocks = cus * per_cu;
  }
  hipMemsetAsync(p.bar, 0, XCD_BAR_WORDS * 4, stream);
#if COOP
  int lo = 0, hi = NPHASE;
  void* args[] = {&p, &lo, &hi};
  hipError_t e = hipLaunchCooperativeKernel((void*)mega, dim3(grid_blocks), dim3(NTHR), args, 0, stream);
  if (e != hipSuccess) fprintf(stderr, "cooperative launch failed: %s (grid %d)\n", hipGetErrorString(e), grid_blocks);
#else
  for (int ph = 0; ph < NPHASE; ++ph) mega<<<grid_blocks, NTHR, 0, stream>>>(p, ph, ph + 1);
#endif
}
```

```cpp
#include <hip/hip_runtime.h>
#include <hip/hip_cooperative_groups.h>
#include <cstdio>
#include <cstring>
#include <cmath>
namespace cg = cooperative_groups;

#ifndef COOP
#define COOP 1
#endif

typedef unsigned short u16;
using bf16x8 = __attribute__((ext_vector_type(8))) short;
using f32x16 = __attribute__((ext_vector_type(16))) float;
using u32x4 = __attribute__((ext_vector_type(4))) unsigned;
using u32x2 = __attribute__((ext_vector_type(2))) unsigned;
#define DI __device__ __forceinline__
#define MFMA(a, b, c) __builtin_amdgcn_mfma_f32_32x32x16_bf16((a), (b), (c), 0, 0, 0)

constexpr int DM = 2048;
constexpr int INW = 5440;
constexpr int INWP = 5504;
constexpr float LOG2E = 1.4426950408889634f;
constexpr int NTHR = 256;
constexpr int SMEM_BYTES = 256 * 144 + 128 * 144 + 1024;

struct GroupP {
  const float* x;
  float* out;
  int B, L, Lp, T;
  int seq0, Hp;
  u16 *xb, *uf, *cq, *ckv, *kr, *qd, *kd, *vdt, *g, *q, *abt, *fm;
  u16* h1b;
};
struct Params {
  GroupP grp[2];
  const float *meta, *rel_bias, *final_norm, *norm_w, *w_in, *w_fmix, *q_norm, *w_uq, *kv_norm, *w_ukv;
  const float *lq1, *lk1, *lq2, *lk2, *diff_norm, *w_o;
  u16 *winT, *wuqT, *wukvT, *woT, *mfT;
  float2* rope;
  float* lam;
  float* hmeta;
  int* ctr;
  unsigned* bar;
  float* rowsq;
  float rope_hi[32], rope_lo[32];
};

DI unsigned pk2(float lo, float hi) {
  typedef __bf16 bf2 __attribute__((ext_vector_type(2)));
  typedef float f2 __attribute__((ext_vector_type(2)));
  f2 v = {lo, hi};
  return __builtin_bit_cast(unsigned, __builtin_convertvector(v, bf2));
}
DI u16 bf1(float x) { return (u16)(pk2(x, 0.f) & 0xffffu); }
DI float bf_lo(unsigned u) { return __uint_as_float(u << 16); }
DI float bf_hi(unsigned u) { return __uint_as_float(u & 0xffff0000u); }
DI int tid_() { int t = threadIdx.x; asm volatile("" : "+v"(t)); return t; }
DI int crow(int i, int h) { return (i & 3) + 8 * (i >> 2) + 4 * h; }
DI float wave_sum(float v) {
#pragma unroll
  for (int o = 32; o >= 1; o >>= 1) v += __shfl_xor(v, o, 64);
  return v;
}

struct ASrc { const u16* p; long ld; };

DI float dot2bf(unsigned a, float c) {
  typedef __bf16 bf2 __attribute__((ext_vector_type(2)));
  bf2 x = __builtin_bit_cast(bf2, a);
  return __builtin_amdgcn_fdot2_f32_bf16(x, x, c, false);
}

template <bool SWAP, bool SSQ, class AF>
DI void gemm_main(AF asrc, int m0, const u16* __restrict__ Bw, int ldb, int K, char* smem,
                  f32x16 (&acc)[4][2], float ssq_eps, float (&rs)[4]) {
  const int tid = tid_(), lane = tid & 63, wid = __builtin_amdgcn_readfirstlane(tid >> 6);
  const int wm = wid >> 1, wn = wid & 1, lr = lane & 31, lh = lane >> 5;
  char* sA = smem;
  char* sB = smem + 256 * 144;
  const int srow = tid >> 3, skc = tid & 7;
  const unsigned lds_st = srow * 144 + skc * 16;
  const unsigned voffB = (unsigned)(srow * ldb * 2 + skc * 16);
  u32x4 ra[8], rb[4];
#pragma unroll
  for (int i = 0; i < 4; ++i) rs[i] = 0.f;
#pragma unroll
  for (int mi = 0; mi < 4; ++mi)
#pragma unroll
    for (int ni = 0; ni < 2; ++ni)
#pragma unroll
      for (int i = 0; i < 16; ++i) acc[mi][ni][i] = 0.f;

  auto gload = [&](int kt) {
    ASrc s = asrc(kt);
    const unsigned voffA = (unsigned)(srow * (int)s.ld * 2 + skc * 16);
    const char* ua = (const char*)s.p + (long)m0 * s.ld * 2;
#pragma unroll
    for (int i = 0; i < 8; ++i) ra[i] = *(const u32x4*)(ua + (long)(32 * i) * s.ld * 2 + voffA);
    const char* ub = (const char*)Bw + (long)kt * 128;
#pragma unroll
    for (int i = 0; i < 4; ++i) rb[i] = *(const u32x4*)(ub + (long)(32 * i) * ldb * 2 + voffB);
  };
  auto sstore = [&]() {
#pragma unroll
    for (int i = 0; i < 8; ++i) *(u32x4*)(sA + lds_st + i * (32 * 144)) = ra[i];
#pragma unroll
    for (int i = 0; i < 4; ++i) *(u32x4*)(sB + lds_st + i * (32 * 144)) = rb[i];
  };

  const int nkt = K >> 6;
  const char* pA = sA + (wm * 128 + lr) * 144 + lh * 16;
  const char* pB = sB + (wn * 64 + lr) * 144 + lh * 16;
  gload(0);
  sstore();
  __syncthreads();
  for (int kt = 0; kt < nkt; ++kt) {
    if (kt + 1 < nkt) gload(kt + 1);
    __builtin_amdgcn_sched_barrier(0);
    {
      bf16x8 ar[3], br[2][2];
      ar[0] = *(const bf16x8*)(pA);
      ar[1] = *(const bf16x8*)(pA + 32 * 144);
      br[0][0] = *(const bf16x8*)(pB);
      br[0][1] = *(const bf16x8*)(pB + 32 * 144);
      __builtin_amdgcn_sched_group_barrier(0x100, 4, 0);
#pragma unroll
      for (int t = 0; t < 16; ++t) {
        const int ks = t >> 2, mi = t & 3;
        if (t + 2 < 16) {
          ar[(t + 2) % 3] = *(const bf16x8*)(pA + ((t + 2) & 3) * (32 * 144) + ((t + 2) >> 2) * 32);
          if (mi == 1 && ks + 1 < 4) {
            br[(ks + 1) & 1][0] = *(const bf16x8*)(pB + (ks + 1) * 32);
            br[(ks + 1) & 1][1] = *(const bf16x8*)(pB + 32 * 144 + (ks + 1) * 32);
            __builtin_amdgcn_sched_group_barrier(0x100, 3, 0);
          } else {
            __builtin_amdgcn_sched_group_barrier(0x100, 1, 0);
          }
        }
        acc[mi][0] = SWAP ? MFMA(br[ks & 1][0], ar[t % 3], acc[mi][0]) : MFMA(ar[t % 3], br[ks & 1][0], acc[mi][0]);
        acc[mi][1] = SWAP ? MFMA(br[ks & 1][1], ar[t % 3], acc[mi][1]) : MFMA(ar[t % 3], br[ks & 1][1], acc[mi][1]);
        __builtin_amdgcn_sched_group_barrier(0x008, 2, 0);
        if (SSQ) {
          u32x4 u = __builtin_bit_cast(u32x4, ar[t % 3]);
#pragma unroll
          for (int j = 0; j < 4; ++j) rs[mi] = dot2bf(u[j], rs[mi]);
        }
      }
    }
    __syncthreads();
    if (kt + 1 < nkt) sstore();
    __syncthreads();
  }
  if (SSQ) {
#pragma unroll
    for (int mi = 0; mi < 4; ++mi) {
      float v = rs[mi] + __shfl_xor(rs[mi], 32, 64);
      rs[mi] = __builtin_amdgcn_rsqf(v / (float)K + ssq_eps);
    }
  }
}

DI int xcd_tile(int it, int total) {
  const int per = (total + 7) >> 3;
  const int j = it >> 3;
  const int t = (it & 7) * per + j;
  return (j < per && t < total) ? t : -1;
}
constexpr int TGM = 4;
DI void tile_mn(int t, int nmt, int nnt, int& mt, int& nt) {
  const int gs = TGM * nnt;
  const int mg = t / gs, r = t - mg * gs;
  const int rem = nmt - mg * TGM;
  const int gsz = rem < TGM ? rem : TGM;
  nt = r / gsz;
  mt = mg * TGM + (r - nt * gsz);
}

DI float silu(float x) { return x * __builtin_amdgcn_rcpf(1.f + __builtin_amdgcn_exp2f(-x * LOG2E)); }

DI void store_bf8_pair(u16* p16, int lh, float a0, float a1, float a2, float a3, float b0, float b1, float b2, float b3) {
  const unsigned pa0 = pk2(a0, a1), pa1 = pk2(a2, a3), pb0 = pk2(b0, b1), pb1 = pk2(b2, b3);
  auto r0 = __builtin_amdgcn_permlane32_swap(pa0, pb0, false, false);
  auto r1 = __builtin_amdgcn_permlane32_swap(pa1, pb1, false, false);
  u32x4 w = {r0[0], r1[0], r0[1], r1[1]};
  *(u32x4*)(p16 + 8 * lh) = w;
}

DI void store_bf4(u16* dst, float a, float b, float c, float d) {
  u32x2 v;
  v[0] = pk2(a, b);
  v[1] = pk2(c, d);
  *(u32x2*)dst = v;
}

DI void wprep_item(const float* __restrict__ src, u16* __restrict__ dst, int K, int N, const float* __restrict__ rowscale,
                   float cs_val, int cs_lo, int cs_hi, int kt, int nt, char* smem) {
  float* t = (float*)smem;
  const int tid = tid_();
#pragma unroll
  for (int i = 0; i < 16; ++i) {
    int k = i * 4 + (tid >> 6), n = tid & 63;
    int gk = kt * 64 + k, gn = nt * 64 + n;
    float v = 0.f;
    if (gn < N) {
      v = src[(long)gk * N + gn];
      if (rowscale) v *= rowscale[gk];
      if (gn >= cs_lo && gn < cs_hi) v *= cs_val;
    }
    t[k * 65 + n] = v;
  }
  __syncthreads();
#pragma unroll
  for (int i = 0; i < 16; ++i) {
    int n = i * 4 + (tid >> 6), k = tid & 63;
    dst[(long)(nt * 64 + n) * K + kt * 64 + k] = bf1(t[k * 65 + n]);
  }
  __syncthreads();
}

typedef const __attribute__((address_space(4))) float* CF;
DI void phase_wprep(const Params& p, CF rope_hi, CF rope_lo, char* smem, int part) {
  const int tid = tid_();
  const int nWin = 32 * 86, nWuq = 12 * 24, nWukv = 8 * 32, nWo = 32 * 32;
  const int perL = nWin + nWuq + nWukv + nWo;
  for (int it = blockIdx.x; it < 2 * perL; it += gridDim.x) {
    int l = it / perL, r = it % perL;
    if (((l == 0 && r < nWin) ? 0 : 1) != part) continue;
    if (r < nWin) {
      wprep_item(p.w_in + (long)l * DM * INW, p.winT + (long)l * INWP * DM, DM, INW, p.norm_w + l * DM,
                 0.125f * LOG2E, 1856, 2368, r / 86, r % 86, smem);
    } else if ((r -= nWin) < nWuq) {
      wprep_item(p.w_uq + (long)l * 768 * 1536, p.wuqT + (long)l * 1536 * 768, 768, 1536, p.q_norm + l * 768,
                 0.07216878364870322f * LOG2E, 0, 1536, r / 24, r % 24, smem);
    } else if ((r -= nWuq) < nWukv) {
      wprep_item(p.w_ukv + (long)l * 512 * 2048, p.wukvT + (long)l * 2048 * 512, 512, 2048, p.kv_norm + l * 512,
                 1.f, 0, 0, r / 32, r % 32, smem);
    } else {
      r -= nWukv;
      wprep_item(p.w_o + (long)l * DM * DM, p.woT + (long)l * DM * DM, DM, DM, nullptr, 1.f, 0, 0, r / 32, r % 32, smem);
    }
  }
  for (int it = blockIdx.x; it < (part == 1 ? 1024 : 0); it += gridDim.x) {
    int o = it * 256 + tid;
    int c = o & 127, n = (o >> 7) & 255, gg = (o >> 15) & 3, l = o >> 17;
    int d = n & 127, part = n >> 7;
    const float* W = p.w_fmix + (long)(l * 4 + gg) * 128 * 128;
    float s = 0.f;
    for (int cp = 0; cp < 128; ++cp) {
      float fr = (float)((c * cp) & 127) * (1.f / 128.f);
      float tr = part ? __builtin_amdgcn_sinf(fr) : __builtin_amdgcn_cosf(fr);
      s += tr * W[cp * 128 + d];
    }
    p.mfT[o] = bf1(s * 0.08838834764831845f);
  }
  for (int it = blockIdx.x; it < (part == 0 ? (8320 * 32) / 256 : 0); it += gridDim.x) {
    int o = it * 256 + tid;
    int c = o & 31, t = o >> 5;
    float tf = (float)t, hi = rope_hi[c], lo = rope_lo[c];
    float pr = tf * hi;
    float er = fmaf(tf, hi, -pr);
    float fr = (pr - floorf(pr)) + (er + tf * lo);
    p.rope[o] = make_float2(__builtin_amdgcn_cosf(fr), __builtin_amdgcn_sinf(fr));
  }
  if (part == 0 && blockIdx.x == 0 && tid < 128) p.ctr[tid] = 0;
  if (part == 0) {
    for (int i = blockIdx.x * NTHR + tid; i < 5 * 50432; i += gridDim.x * NTHR) p.rowsq[i] = 0.f;
    for (int gi = 0; gi < 2; ++gi) {
      const GroupP& g = p.grp[gi];
      const int npad = g.Lp - g.L;
      const int total = g.B * npad * (DM / 8);
      for (int i = blockIdx.x * NTHR + tid; i < total; i += gridDim.x * NTHR) {
        const int c = i % (DM / 8), rr = i / (DM / 8);
        const int b = rr / npad, t = g.L + (rr - b * npad);
        unsigned zz = 0u; asm volatile("" : "+v"(zz)); u32x4 z = {zz, zz, zz, zz};
        *(u32x4*)(g.h1b + ((long)(b * g.Lp + t)) * DM + c * 8) = z;
      }
    }
  }
  if (part == 1 && blockIdx.x == 0 && tid < 2) {
    int l = tid;
    float a = 0.f, b = 0.f;
    for (int i = 0; i < 64; ++i) {
      a += p.lq1[l * 64 + i] * p.lk1[l * 64 + i];
      b += p.lq2[l * 64 + i] * p.lk2[l * 64 + i];
    }
    float lam_init = l ? 0.35550906759f : 0.2f;
    p.lam[l] = __builtin_amdgcn_exp2f(a * LOG2E) - __builtin_amdgcn_exp2f(b * LOG2E) + lam_init;
  }
}

DI void phase_rowprep(const Params& p, const GroupP& g, int l, int vb) {
  const int tid = tid_(), lane = tid & 63, wid = __builtin_amdgcn_readfirstlane(tid >> 6);
  for (int it = vb; it < g.T / 4; it += gridDim.x) {
    int row = it * 4 + wid;
    int b = row / g.Lp, t = row - b * g.Lp;
    u16* dst = g.xb + (long)row * DM;
    if (t >= g.L) {
      unsigned zz = 0u; asm volatile("" : "+v"(zz)); u32x4 z = {zz, zz, zz, zz};
#pragma unroll
      for (int i = 0; i < 4; ++i) *(u32x4*)(dst + (i * 64 + lane) * 8) = z;
      continue;
    }
    if (l == 0) {
      const float* src = (t < 16) ? p.meta + t * DM : g.x + ((long)b * (g.L - 16) + (t - 16)) * DM;
      float4 v[8];
      float ss = 0.f;
#pragma unroll
      for (int i = 0; i < 8; ++i) {
        v[i] = *(const float4*)(src + (i * 64 + lane) * 4);
        ss += v[i].x * v[i].x + v[i].y * v[i].y + v[i].z * v[i].z + v[i].w * v[i].w;
      }
      ss = wave_sum(ss);
      float r = __builtin_amdgcn_rsqf(ss * (1.f / DM) + 1e-6f);
#pragma unroll
      for (int i = 0; i < 8; ++i) store_bf4(dst + (i * 64 + lane) * 4, v[i].x * r, v[i].y * r, v[i].z * r, v[i].w * r);
    } else {
      const u16* src = g.h1b + (long)row * DM;
      u32x4 v[4];
      float ss = 0.f;
#pragma unroll
      for (int i = 0; i < 4; ++i) {
        v[i] = *(const u32x4*)(src + (i * 64 + lane) * 8);
#pragma unroll
        for (int j = 0; j < 4; ++j) { float a = bf_lo(v[i][j]), c = bf_hi(v[i][j]); ss += a * a + c * c; }
      }
      ss = wave_sum(ss);
      float r = __builtin_amdgcn_rsqf(ss * (1.f / DM) + 1e-6f);
#pragma unroll
      for (int i = 0; i < 4; ++i) {
        u32x4 o;
#pragma unroll
        for (int j = 0; j < 4; ++j) o[j] = pk2(bf_lo(v[i][j]) * r, bf_hi(v[i][j]) * r);
        *(u32x4*)(dst + (i * 64 + lane) * 8) = o;
      }
    }
  }
}

DI void phase_dftfill(const GroupP& g, int vb) {
  const int tid = tid_();
  const int L = g.L, Lp = g.Lp, Hp = g.Hp, H = L >> 1;
  const float invL = 1.f / (float)L, nrm = 1.f / sqrtf((float)L);
  const int nch = (2 * Hp) / 8;
  const int krows = (Hp + 255) / 256 * 256;
  for (int k = vb; k < krows; k += gridDim.x) {
    u16* rowp = g.fm + (long)k * (2 * Hp);
    for (int ch = tid; ch < nch; ch += NTHR) {
      int kk0 = ch * 8;
      int part = kk0 >= Hp;
      int s0 = kk0 - part * Hp;
      float v[8];
      if (k > H) {
#pragma unroll
        for (int j = 0; j < 8; ++j) v[j] = 0.f;
      } else {
        unsigned prod = (unsigned)k * (unsigned)s0;
        int jj = (L == 8208) ? (int)(prod % 8208u) : (int)(prod % 4112u);
#pragma unroll
        for (int j = 0; j < 8; ++j) {
          float fr = (float)jj * invL;
          float tr = part ? -__builtin_amdgcn_sinf(fr) : __builtin_amdgcn_cosf(fr);
          v[j] = (s0 + j <= H) ? tr * nrm : 0.f;
          jj += k;
          if (jj >= L) jj -= L;
        }
      }
      u32x4 o;
      o[0] = pk2(v[0], v[1]); o[1] = pk2(v[2], v[3]); o[2] = pk2(v[4], v[5]); o[3] = pk2(v[6], v[7]);
      *(u32x4*)(rowp + kk0) = o;
    }
  }
}

DI void rope_store(const f32x16& a0, const f32x16& a1, const float2* __restrict__ ropet, u16* dst, int lh) {
#pragma unroll
  for (int pr = 0; pr < 2; ++pr) {
    float o1[2][4], o2[2][4];
#pragma unroll
    for (int e = 0; e < 2; ++e) {
      const int gi = 2 * pr + e;
      const int c0 = 8 * gi + 4 * lh;
      float4 t01 = *(const float4*)(ropet + c0);
      float4 t23 = *(const float4*)(ropet + c0 + 2);
      float cs[4] = {t01.x, t01.z, t23.x, t23.z};
      float sn[4] = {t01.y, t01.w, t23.y, t23.w};
#pragma unroll
      for (int j = 0; j < 4; ++j) {
        float x1 = a0[4 * gi + j], x2 = a1[4 * gi + j];
        o1[e][j] = x1 * cs[j] - x2 * sn[j];
        o2[e][j] = x2 * cs[j] + x1 * sn[j];
      }
    }
    store_bf8_pair(dst + 16 * pr, lh, o1[0][0], o1[0][1], o1[0][2], o1[0][3], o1[1][0], o1[1][1], o1[1][2], o1[1][3]);
    store_bf8_pair(dst + 32 + 16 * pr, lh, o2[0][0], o2[0][1], o2[0][2], o2[0][3], o2[1][0], o2[1][1], o2[1][2], o2[1][3]);
  }
}

DI void phase_inproj(const Params& p, const GroupP& g, int l, char* smem, int vb) {
  const int tid = tid_(), lane = tid & 63, wid = __builtin_amdgcn_readfirstlane(tid >> 6);
  const int wm = wid >> 1, wn = wid & 1, lr = lane & 31, lh = lane >> 5;
  const int nmt = g.T / 256;
  const u16* W = p.winT + (long)l * INWP * DM;
  const int ntiles = nmt * 43;
  for (int it = vb; it < ((ntiles + 7) & ~7); it += gridDim.x) {
    const int tt = xcd_tile(it, ntiles);
    if (tt < 0) continue;
    int nt, mt;
    tile_mn(tt, nmt, 43, mt, nt);
    int m0 = mt * 256, n0 = nt * 128;
    f32x16 acc[4][2];
    const u16* xb = (l == 0) ? g.xb : g.h1b;
    float rsd[4];
    gemm_main<true, false>([&](int kt) { return ASrc{xb + kt * 64, DM}; }, m0, W + (long)n0 * DM, DM, DM, smem, acc, 0.f, rsd);
    const int nw0 = n0 + wn * 64;
    if (nw0 >= INW) continue;
    if (l == 1) {
      const float* sq = p.rowsq + (size_t)4 * 50432 + g.seq0 + m0 + wm * 128 + lr;
#pragma unroll
      for (int mi = 0; mi < 4; ++mi) {
        const float r = __builtin_amdgcn_rsqf(sq[mi * 32] * (1.f / DM) + 1e-6f);
#pragma unroll
        for (int ni = 0; ni < 2; ++ni)
#pragma unroll
          for (int i = 0; i < 16; ++i) acc[mi][ni][i] *= r;
      }
    }
#pragma unroll
    for (int mi = 0; mi < 4; ++mi) {
      int m = m0 + wm * 128 + mi * 32 + lr;
      int b = m / g.Lp, t = m - b * g.Lp;
      if (nw0 == 1792) {
        rope_store(acc[mi][0], acc[mi][1], p.rope + t * 32, g.kr + (long)m * 64, lh);
      } else if (nw0 >= 2880 && nw0 < 3392) {
#pragma unroll
        for (int ni = 0; ni < 2; ++ni)
#pragma unroll
          for (int i = 0; i < 16; ++i) {
            const long uoff = (long)(nw0 - 2880 + ni * 32 + (i & 3) + 8 * (i >> 2)) * g.Lp * 2;
            const unsigned voff = (unsigned)(((b * 512 + 4 * lh) * g.Lp + t) * 2);
            *(u16*)((char*)g.vdt + uoff + voff) = bf1(acc[mi][ni][i]);
          }
      } else {
        u16* dst; int ld, base; bool sil = false;
        if (nw0 < 512) { dst = g.uf; ld = 512; base = 0; }
        else if (nw0 < 1280) { dst = g.cq; ld = 768; base = 512; }
        else if (nw0 < 1792) { dst = g.ckv; ld = 512; base = 1280; }
        else if (nw0 < 2368) { dst = g.qd; ld = 512; base = 1856; }
        else if (nw0 < 2880) { dst = g.kd; ld = 512; base = 2368; }
        else { dst = g.g; ld = 2048; base = 3392; sil = true; }
        if (nw0 >= 512 && nw0 < 1792) {
          float ss = 0.f;
#pragma unroll
          for (int ni = 0; ni < 2; ++ni)
#pragma unroll
            for (int i = 0; i < 16; ++i) ss += acc[mi][ni][i] * acc[mi][ni][i];
          atomicAdd(p.rowsq + (size_t)(l * 2 + (nw0 >= 1280 ? 1 : 0)) * 50432 + g.seq0 + m, ss);
        }
#pragma unroll
        for (int ni = 0; ni < 2; ++ni)
#pragma unroll
          for (int pr = 0; pr < 2; ++pr) {
            int n = nw0 - base + ni * 32 + 16 * pr;
            float v[8];
#pragma unroll
            for (int j = 0; j < 8; ++j) v[j] = acc[mi][ni][8 * pr + j];
            if (sil) {
#pragma unroll
              for (int j = 0; j < 8; ++j) v[j] = silu(v[j]);
            }
            store_bf8_pair(dst + (long)m * ld + n, lh, v[0], v[1], v[2], v[3], v[4], v[5], v[6], v[7]);
          }
      }
    }
  }
}

DI void phase_upproj(const Params& p, const GroupP& g, int l, char* smem, int vb) {
  const int tid = tid_(), lane = tid & 63, wid = __builtin_amdgcn_readfirstlane(tid >> 6);
  const int wm = wid >> 1, wn = wid & 1, lr = lane & 31, lh = lane >> 5;
  const int nmt = g.T / 256;
  u16* kn = g.xb;
  u16* vt = g.xb + (long)g.T * 1024;
  const int ntiles = nmt * 28;
  for (int it = vb; it < ((ntiles + 7) & ~7); it += gridDim.x) {
    const int tt = xcd_tile(it, ntiles);
    if (tt < 0) continue;
    int nt, mt;
    tile_mn(tt, nmt, 28, mt, nt);
    int m0 = mt * 256;
    f32x16 acc[4][2];
    float rs[4];
    if (nt < 28) {
      const bool isq = nt < 12;
      const int n0 = isq ? nt * 128 : (nt - 12) * 128;
      const u16* A = isq ? g.cq : g.ckv;
      const int Kd = isq ? 768 : 512;
      const u16* Bw = isq ? p.wuqT + (long)l * 1536 * 768 + (long)n0 * 768 : p.wukvT + (long)l * 2048 * 512 + (long)n0 * 512;
      gemm_main<true, false>([&](int kt) { return ASrc{A + kt * 64, (long)Kd}; }, m0, Bw, Kd, Kd, smem, acc, 0.f, rs);
      {
        const float* sq = p.rowsq + (size_t)(l * 2 + (isq ? 0 : 1)) * 50432 + g.seq0 + m0 + wm * 128 + lr;
        const float invK = 1.f / (float)Kd;
#pragma unroll
        for (int mi = 0; mi < 4; ++mi) rs[mi] = __builtin_amdgcn_rsqf(sq[mi * 32] * invK + 1e-6f);
      }
      const int nw0 = n0 + wn * 64;
      if (isq) {
        const int head = nw0 / 192, w = nw0 - head * 192;
#pragma unroll
        for (int mi = 0; mi < 4; ++mi) {
          int m = m0 + wm * 128 + mi * 32 + lr;
          float r = rs[mi];
          if (w == 128) {
            int b = m / g.Lp, t = m - b * g.Lp;
            f32x16 a0 = acc[mi][0], a1 = acc[mi][1];
#pragma unroll
            for (int i = 0; i < 16; ++i) { a0[i] *= r; a1[i] *= r; }
            rope_store(a0, a1, p.rope + t * 32, g.q + (long)m * 1536 + nw0, lh);
          } else {
            u16* qp = g.q + (long)m * 1536 + nw0;
#pragma unroll
            for (int ni = 0; ni < 2; ++ni)
#pragma unroll
              for (int pr = 0; pr < 2; ++pr)
                store_bf8_pair(qp + ni * 32 + 16 * pr, lh, acc[mi][ni][8 * pr] * r, acc[mi][ni][8 * pr + 1] * r,
                               acc[mi][ni][8 * pr + 2] * r, acc[mi][ni][8 * pr + 3] * r, acc[mi][ni][8 * pr + 4] * r,
                               acc[mi][ni][8 * pr + 5] * r, acc[mi][ni][8 * pr + 6] * r, acc[mi][ni][8 * pr + 7] * r);
          }
        }
      } else {
        const int head = n0 >> 8, isv = (n0 >> 7) & 1;
        if (!isv) {
#pragma unroll
          for (int mi = 0; mi < 4; ++mi) {
            int m = m0 + wm * 128 + mi * 32 + lr;
            float r = rs[mi];
            u16* kp = kn + (long)m * 1024 + head * 128 + wn * 64;
#pragma unroll
            for (int ni = 0; ni < 2; ++ni)
#pragma unroll
              for (int pr = 0; pr < 2; ++pr)
                store_bf8_pair(kp + ni * 32 + 16 * pr, lh, acc[mi][ni][8 * pr] * r, acc[mi][ni][8 * pr + 1] * r,
                               acc[mi][ni][8 * pr + 2] * r, acc[mi][ni][8 * pr + 3] * r, acc[mi][ni][8 * pr + 4] * r,
                               acc[mi][ni][8 * pr + 5] * r, acc[mi][ni][8 * pr + 6] * r, acc[mi][ni][8 * pr + 7] * r);
          }
        } else {
#pragma unroll
          for (int mi = 0; mi < 4; ++mi) {
            int m = m0 + wm * 128 + mi * 32 + lr;
            float r = rs[mi];
            int b = m / g.Lp, t = m - b * g.Lp;
            const unsigned voff = (unsigned)((((b * 8 + head) * 128 + 4 * lh) * g.Lp + t) * 2);
#pragma unroll
            for (int ni = 0; ni < 2; ++ni)
#pragma unroll
              for (int i = 0; i < 16; ++i) {
                const long uoff = (long)(wn * 64 + ni * 32 + (i & 3) + 8 * (i >> 2)) * g.Lp * 2;
                *(u16*)((char*)vt + uoff + voff) = bf1(acc[mi][ni][i] * r);
              }
          }
        }
      }
    }
  }
  {
    const int Hp = g.Hp, H = g.L >> 1, L = g.L, Lp = g.Lp;
    const int nft = (g.B * Hp) / 256;
    const int srow = tid >> 3, skc = tid & 7;
    char* sA = smem;
    char* sB = smem + 256 * 144;
    for (int it = vb; it < nft * 8; it += gridDim.x) {
      const int nt = it / nft, mt = it - nt * nft;
      const int m0 = mt * 256, n0 = nt * 128;
      const int gg = n0 >> 8, part = (n0 >> 7) & 1;
      const u16* Bw = p.mfT + (long)(l * 4 + gg) * 256 * 128 + (long)(n0 & 255) * 128;
      f32x16 acc[4][2];
#pragma unroll
      for (int mi = 0; mi < 4; ++mi)
#pragma unroll
        for (int ni = 0; ni < 2; ++ni)
#pragma unroll
          for (int i = 0; i < 16; ++i) acc[mi][ni][i] = 0.f;
      for (int kt = 0; kt < 2; ++kt) {
#pragma unroll
        for (int i = 0; i < 8; ++i) {
          const int row = srow + 32 * i;
          const int m = m0 + row;
          const int b = m / Hp, sidx = m - b * Hp;
          const bool pair = sidx >= 1 && sidx < H;
          const bool v1ok = (sidx <= H) && (pair || !part);
          u32x4 v1 = {0u, 0u, 0u, 0u}, v2 = {0u, 0u, 0u, 0u};
          if (v1ok) v1 = *(const u32x4*)(g.uf + ((long)(b * Lp + sidx)) * 512 + gg * 128 + kt * 64 + skc * 8);
          if (pair) v2 = *(const u32x4*)(g.uf + ((long)(b * Lp + L - sidx)) * 512 + gg * 128 + kt * 64 + skc * 8);
          u32x4 o;
#pragma unroll
          for (int j = 0; j < 4; ++j) {
            float a0 = bf_lo(v1[j]), a1 = bf_hi(v1[j]), b0 = bf_lo(v2[j]), b1 = bf_hi(v2[j]);
            o[j] = part ? pk2(a0 - b0, a1 - b1) : pk2(a0 + b0, a1 + b1);
          }
          *(u32x4*)(sA + row * 144 + skc * 16) = o;
        }
#pragma unroll
        for (int i = 0; i < 4; ++i)
          *(u32x4*)(sB + (srow + 32 * i) * 144 + skc * 16) = *(const u32x4*)(Bw + (long)(srow + 32 * i) * 128 + kt * 64 + skc * 8);
        __syncthreads();
#pragma unroll
        for (int ks = 0; ks < 4; ++ks) {
          bf16x8 af[4], bfr[2];
#pragma unroll
          for (int mi = 0; mi < 4; ++mi) af[mi] = *(const bf16x8*)(sA + (wm * 128 + mi * 32 + lr) * 144 + ks * 32 + lh * 16);
#pragma unroll
          for (int ni = 0; ni < 2; ++ni) bfr[ni] = *(const bf16x8*)(sB + (wn * 64 + ni * 32 + lr) * 144 + ks * 32 + lh * 16);
#pragma unroll
          for (int mi = 0; mi < 4; ++mi)
#pragma unroll
            for (int ni = 0; ni < 2; ++ni) acc[mi][ni] = MFMA(af[mi], bfr[ni], acc[mi][ni]);
        }
        __syncthreads();
      }
#pragma unroll
      for (int mi = 0; mi < 4; ++mi)
#pragma unroll
        for (int gi = 0; gi < 4; ++gi) {
          const int m = m0 + wm * 128 + mi * 32 + 8 * gi + 4 * lh;
          const int b = m / Hp, sidx = m - b * Hp;
#pragma unroll
          for (int ni = 0; ni < 2; ++ni) {
            const int d = wn * 64 + ni * 32 + lr;
            store_bf4(g.abt + ((long)(b * 512 + gg * 128 + d)) * (2 * Hp) + part * Hp + sidx, acc[mi][ni][4 * gi],
                      acc[mi][ni][4 * gi + 1], acc[mi][ni][4 * gi + 2], acc[mi][ni][4 * gi + 3]);
          }
        }
    }
  }
}

constexpr float SM_THR = 8.f;
DI void softmax_pv(f32x16 (&sa)[2], f32x16 (&O)[4], float& m, float& l, const char* sV, int lr, int lh, bool first) {
  float t0 = fmaxf(fmaxf(sa[0][0], sa[0][1]), sa[0][2]);
  float t1 = fmaxf(fmaxf(sa[1][0], sa[1][1]), sa[1][2]);
#pragma unroll
  for (int i = 3; i < 15; i += 2) {
    t0 = fmaxf(fmaxf(t0, sa[0][i]), sa[0][i + 1]);
    t1 = fmaxf(fmaxf(t1, sa[1][i]), sa[1][i + 1]);
  }
  float tmax = fmaxf(fmaxf(t0, t1), fmaxf(sa[0][15], sa[1][15]));
  tmax = fmaxf(tmax, __shfl_xor(tmax, 32, 64));
  if (first || __any(tmax > SM_THR)) {
    asm volatile("; rescale" ::: "memory");
    const float delta = first ? tmax : fmaxf(tmax, 0.f);
    const float alpha = __builtin_amdgcn_exp2f(-delta);
    m += delta;
    l *= alpha;
#pragma unroll
    for (int d = 0; d < 4; ++d)
#pragma unroll
      for (int i = 0; i < 16; ++i) O[d][i] *= alpha;
#pragma unroll
    for (int i = 0; i < 16; ++i) { sa[0][i] -= delta; sa[1][i] -= delta; }
  }
  float rsum0 = 0.f, rsum1 = 0.f;
#pragma unroll
  for (int i = 0; i < 16; ++i) {
    float p0 = __builtin_amdgcn_exp2f(sa[0][i]);
    float p1 = __builtin_amdgcn_exp2f(sa[1][i]);
    sa[0][i] = p0;
    sa[1][i] = p1;
    rsum0 += p0;
    rsum1 += p1;
  }
  l += rsum0 + rsum1;
  bf16x8 pf[4];
#pragma unroll
  for (int g4 = 0; g4 < 4; ++g4) {
    const int kb = g4 >> 1, s2 = g4 & 1;
    u32x4 pp;
#pragma unroll
    for (int j = 0; j < 4; ++j) pp[j] = pk2(sa[kb][8 * s2 + 2 * j], sa[kb][8 * s2 + 2 * j + 1]);
    pf[g4] = __builtin_bit_cast(bf16x8, pp);
  }
  const char* vrd = sV + lr * 144 + lh * 16;
  bf16x8 vfr[4];
#pragma unroll
  for (int t = 0; t < 3; ++t) vfr[t] = *(const bf16x8*)(vrd + (t & 3) * (32 * 144) + (t >> 2) * 32);
  __builtin_amdgcn_sched_group_barrier(0x100, 3, 0);
#pragma unroll
  for (int t = 0; t < 16; ++t) {
    if (t + 3 < 16) {
      vfr[(t + 3) & 3] = *(const bf16x8*)(vrd + ((t + 3) & 3) * (32 * 144) + ((t + 3) >> 2) * 32);
      __builtin_amdgcn_sched_group_barrier(0x100, 1, 0);
    }
    O[t & 3] = MFMA(vfr[t & 3], pf[t >> 2], O[t & 3]);
    __builtin_amdgcn_sched_group_barrier(0x008, 1, 0);
  }
}

DI void load_vtile(u32x4 (&rv)[4], const u16* __restrict__ vbase, int Lp, int key0, unsigned voffV) {
  const char* ub = (const char*)vbase + (long)key0 * 2;
#pragma unroll
  for (int i = 0; i < 4; ++i) rv[i] = *(const u32x4*)(ub + (long)(32 * i) * Lp * 2 + voffV);
}
DI void store_vtile(const u32x4 (&rv)[4], char* sVst) {
#pragma unroll
  for (int i = 0; i < 4; ++i) {
    u32x2 lo = {rv[i][0], rv[i][1]}, hi = {rv[i][2], rv[i][3]};
    *(u32x2*)(sVst + i * 4608) = lo;
    *(u32x2*)(sVst + i * 4608 + 16) = hi;
  }
}

DI void mla_item(const Params& p, const GroupP& g, int item, char* smem, bool dry) {
  const int tid = tid_(), lane = tid & 63, wid = __builtin_amdgcn_readfirstlane(tid >> 6), lr = lane & 31, lh = lane >> 5;
  const int nqb = g.Lp / 128;
  const int qb = item % nqb, bh = item / nqb, h = bh & 7, b = bh >> 3;
  const int Lp = g.Lp, L = g.L;
  char* sK = smem;
  char* sV = smem + 64 * 400;
  const u16* kn = g.xb + (long)b * Lp * 1024 + h * 128;
  const u16* kr = g.kr + (long)b * Lp * 64;
  const u16* vbase = g.xb + (long)g.T * 1024 + (long)(b * 8 + h) * 128 * Lp;
  const int qrow = b * Lp + qb * 128 + wid * 32 + lr;
  bf16x8 qf[12];
#pragma unroll
  for (int ks = 0; ks < 12; ++ks) qf[ks] = *(const bf16x8*)(g.q + (long)qrow * 1536 + h * 192 + ks * 16 + lh * 8);
  f32x16 O[4];
#pragma unroll
  for (int d = 0; d < 4; ++d)
#pragma unroll
    for (int i = 0; i < 16; ++i) O[d][i] = 0.f;
  float m = 0.f, l = 0.f;
  const int nkt = (L + 63) >> 6;
  u32x4 rk[6], rv[4];
  const unsigned voffKn = (unsigned)((tid >> 4) * 2048 + (tid & 15) * 16);
  const unsigned voffKr = (unsigned)((tid >> 3) * 128 + (tid & 7) * 16);
  const unsigned voffV = (unsigned)(((tid >> 3) * Lp + (tid & 7) * 8) * 2);
  char* sKn_st = sK + (tid >> 4) * 400 + (tid & 15) * 16;
  char* sKr_st = sK + (tid >> 3) * 400 + 256 + (tid & 7) * 16;
  char* sV_st = sV + (tid >> 3) * 144 + ((tid & 7) >> 1) * 32 + (tid & 1) * 8;
  auto loadK = [&](int kt) {
    const char* u1 = (const char*)kn + (long)kt * (64 * 2048);
#pragma unroll
    for (int i = 0; i < 4; ++i) rk[i] = *(const u32x4*)(u1 + i * (16 * 2048) + voffKn);
    const char* u2 = (const char*)kr + (long)kt * (64 * 128);
#pragma unroll
    for (int i = 0; i < 2; ++i) rk[4 + i] = *(const u32x4*)(u2 + i * (32 * 128) + voffKr);
  };
  auto storeK = [&]() {
#pragma unroll
    for (int i = 0; i < 4; ++i) *(u32x4*)(sKn_st + i * 6400) = rk[i];
#pragma unroll
    for (int i = 0; i < 2; ++i) *(u32x4*)(sKr_st + i * 12800) = rk[4 + i];
  };
  loadK(0);
  load_vtile(rv, vbase, Lp, 0, voffV);
  storeK();
  store_vtile(rv, sV_st);
  __syncthreads();
  for (int kt = 0; kt < nkt; ++kt) {
    const bool more = kt + 1 < nkt;
    if (more) loadK(kt + 1);
    __builtin_amdgcn_sched_barrier(0);
    f32x16 sa[2];
#pragma unroll
    for (int i = 0; i < 16; ++i) { sa[0][i] = -m; sa[1][i] = -m; }
    {
      const char* krd = sK + lr * 400 + lh * 16;
      bf16x8 kf[3][2];
#pragma unroll
      for (int q2 = 0; q2 < 2; ++q2) {
        kf[q2][0] = *(const bf16x8*)(krd + q2 * 32);
        kf[q2][1] = *(const bf16x8*)(krd + 32 * 400 + q2 * 32);
      }
      __builtin_amdgcn_sched_group_barrier(0x100, 4, 0);
#pragma unroll
      for (int ks = 0; ks < 12; ++ks) {
        if (ks + 2 < 12) {
          kf[(ks + 2) % 3][0] = *(const bf16x8*)(krd + (ks + 2) * 32);
          kf[(ks + 2) % 3][1] = *(const bf16x8*)(krd + 32 * 400 + (ks + 2) * 32);
          __builtin_amdgcn_sched_group_barrier(0x100, 2, 0);
        }
        sa[0] = MFMA(kf[ks % 3][0], qf[ks], sa[0]);
        sa[1] = MFMA(kf[ks % 3][1], qf[ks], sa[1]);
        __builtin_amdgcn_sched_group_barrier(0x008, 2, 0);
      }
    }
    if (kt == nkt - 1) {
      asm volatile("; masked tail tile" ::: "memory");
#pragma unroll
      for (int kb = 0; kb < 2; ++kb)
#pragma unroll
        for (int i = 0; i < 16; ++i)
          if (kt * 64 + kb * 32 + crow(i, lh) >= L) sa[kb][i] = -1e30f;
    }
    __syncthreads();
    if (more) { storeK(); load_vtile(rv, vbase, Lp, (kt + 1) * 64, voffV); }
    __builtin_amdgcn_sched_barrier(0);
    softmax_pv(sa, O, m, l, sV, lr, lh, kt == 0);
    __syncthreads();
    if (more) store_vtile(rv, sV_st);
  }
  float lt = l + __shfl_xor(l, 32, 64);
  float inv = 1.f / lt;
  const u16* gp = g.g + (long)qrow * 2048 + 512 + h * 128;
  u16* op = (dry ? (u16*)g.out : g.q) + (long)qrow * 1536 + h * 192;
#pragma unroll
  for (int d = 0; d < 4; ++d)
#pragma unroll
    for (int pr = 0; pr < 2; ++pr) {
      const int dd = d * 32 + 16 * pr;
      const u32x2 ga = *(const u32x2*)(gp + dd + 4 * lh);
      const u32x2 gb = *(const u32x2*)(gp + dd + 8 + 4 * lh);
      store_bf8_pair(op + dd, lh, O[d][8 * pr] * inv * bf_lo(ga[0]), O[d][8 * pr + 1] * inv * bf_hi(ga[0]),
                     O[d][8 * pr + 2] * inv * bf_lo(ga[1]), O[d][8 * pr + 3] * inv * bf_hi(ga[1]),
                     O[d][8 * pr + 4] * inv * bf_lo(gb[0]), O[d][8 * pr + 5] * inv * bf_hi(gb[0]),
                     O[d][8 * pr + 6] * inv * bf_lo(gb[1]), O[d][8 * pr + 7] * inv * bf_hi(gb[1]));
    }
  __syncthreads();
}

DI int t5_bucket(int rel) {
  int n = rel < 0 ? -rel : rel;
  int bk;
  if (n < 8) bk = n;
  else if (n < 12) bk = 8;
  else if (n < 16) bk = 9;
  else if (n < 23) bk = 10;
  else if (n < 32) bk = 11;
  else if (n < 46) bk = 12;
  else if (n < 64) bk = 13;
  else if (n < 91) bk = 14;
  else bk = 15;
  return bk + (rel > 0 ? 16 : 0);
}

DI void diff_item(const Params& p, const GroupP& g, int l_layer, int item, char* smem, bool dry) {
  const int tid = tid_(), lane = tid & 63, wid = __builtin_amdgcn_readfirstlane(tid >> 6), lr = lane & 31, lh = lane >> 5;
  const int nqb = (g.L + 63) / 64;
  const int qb = item % nqb, bh = item / nqb, h = bh & 3, b = bh >> 2;
  const int Lp = g.Lp, L = g.L;
  const int map = wid >> 1, qs = wid & 1;
  char* sK = smem;
  char* sV = smem + 64 * 272;
  float* sBias = (float*)(smem + 64 * 272 + 128 * 144);
  float* o2buf = (float*)smem;
  const u16* kd = g.kd + (long)b * Lp * 512 + h * 128;
  const u16* vbase = g.vdt + (long)(b * 4 + h) * 128 * Lp;
  const int qpos = qb * 64 + qs * 32 + lr;
  const long qrow = (long)b * Lp + qpos;
  for (int i = tid; i < 257; i += NTHR) sBias[i] = p.rel_bias[t5_bucket(i - 128) * 4 + h] * LOG2E;
  const float bneg = p.rel_bias[15 * 4 + h] * LOG2E, bpos = p.rel_bias[31 * 4 + h] * LOG2E;
  bf16x8 qf[4];
#pragma unroll
  for (int ks = 0; ks < 4; ++ks) qf[ks] = *(const bf16x8*)(g.qd + qrow * 512 + h * 128 + map * 64 + ks * 16 + lh * 8);
  f32x16 O[4];
#pragma unroll
  for (int d = 0; d < 4; ++d)
#pragma unroll
    for (int i = 0; i < 16; ++i) O[d][i] = 0.f;
  float m = 0.f, l = 0.f;
  const int nkt = (L + 63) >> 6;
  u32x4 rk[4], rv[4];
  const unsigned voffK = (unsigned)((tid >> 4) * 1024 + (tid & 15) * 16);
  const unsigned voffV = (unsigned)(((tid >> 3) * Lp + (tid & 7) * 8) * 2);
  char* sK_st = sK + (tid >> 4) * 272 + (tid & 15) * 16;
  char* sV_st = sV + (tid >> 3) * 144 + ((tid & 7) >> 1) * 32 + (tid & 1) * 8;
  auto loadK = [&](int kt) {
    const char* u1 = (const char*)kd + (long)kt * (64 * 1024);
#pragma unroll
    for (int i = 0; i < 4; ++i) rk[i] = *(const u32x4*)(u1 + i * (16 * 1024) + voffK);
  };
  auto storeK = [&]() {
#pragma unroll
    for (int i = 0; i < 4; ++i) *(u32x4*)(sK_st + i * (16 * 272)) = rk[i];
  };
  const int qw0 = qb * 64 + qs * 32;
  loadK(0);
  load_vtile(rv, vbase, Lp, 0, voffV);
  storeK();
  store_vtile(rv, sV_st);
  __syncthreads();
  for (int kt = 0; kt < nkt; ++kt) {
    const bool more = kt + 1 < nkt;
    if (more) loadK(kt + 1);
    __builtin_amdgcn_sched_barrier(0);
    const int key0 = kt * 64;
    const int relmin = key0 - (qw0 + 31), relmax = key0 + 63 - qw0;
    const bool farp = relmin >= 128, farn = relmax <= -128;
    const float binit = (farp ? bpos : (farn ? bneg : 0.f)) - m;
    f32x16 sa[2];
#pragma unroll
    for (int i = 0; i < 16; ++i) { sa[0][i] = binit; sa[1][i] = binit; }
    {
      const char* krd = sK + lr * 272 + map * 128 + lh * 16;
      bf16x8 kf[4][2];
#pragma unroll
      for (int ks = 0; ks < 4; ++ks) {
        kf[ks][0] = *(const bf16x8*)(krd + ks * 32);
        kf[ks][1] = *(const bf16x8*)(krd + 32 * 272 + ks * 32);
      }
#pragma unroll
      for (int ks = 0; ks < 4; ++ks) {
        sa[0] = MFMA(kf[ks][0], qf[ks], sa[0]);
        sa[1] = MFMA(kf[ks][1], qf[ks], sa[1]);
      }
    }
    if (!farp && !farn) {
      asm volatile("; near-diagonal bias tile" ::: "memory");
#pragma unroll
      for (int kb = 0; kb < 2; ++kb)
#pragma unroll
        for (int i = 0; i < 16; ++i) {
          int rel = key0 + kb * 32 + crow(i, lh) - qpos;
          rel = rel < -128 ? -128 : (rel > 128 ? 128 : rel);
          sa[kb][i] += sBias[rel + 128];
        }
    }
    if (kt == nkt - 1) {
      asm volatile("; masked tail tile" ::: "memory");
#pragma unroll
      for (int kb = 0; kb < 2; ++kb)
#pragma unroll
        for (int i = 0; i < 16; ++i)
          if (key0 + kb * 32 + crow(i, lh) >= L) sa[kb][i] = -1e30f;
    }
    __syncthreads();
    if (more) { storeK(); load_vtile(rv, vbase, Lp, (kt + 1) * 64, voffV); }
    __builtin_amdgcn_sched_barrier(0);
    softmax_pv(sa, O, m, l, sV, lr, lh, kt == 0);
    __syncthreads();
    if (more) store_vtile(rv, sV_st);
  }
  float lt = l + __shfl_xor(l, 32, 64);
  float inv = 1.f / lt;
  if (map == 1) {
#pragma unroll
    for (int d = 0; d < 4; ++d)
#pragma unroll
      for (int i = 0; i < 16; ++i) o2buf[(d * 32 + crow(i, lh)) * 64 + qs * 32 + lr] = O[d][i] * inv;
  }
  __syncthreads();
  if (map == 0) {
    const float lam = p.lam[l_layer];
    const float lam_init = l_layer ? 0.35550906759f : 0.2f;
    float ss = 0.f;
#pragma unroll
    for (int d = 0; d < 4; ++d)
#pragma unroll
      for (int i = 0; i < 16; ++i) {
        float o = O[d][i] * inv - lam * o2buf[(d * 32 + crow(i, lh)) * 64 + qs * 32 + lr];
        O[d][i] = o;
        ss += o * o;
      }
    ss += __shfl_xor(ss, 32, 64);
    float r = __builtin_amdgcn_rsqf(ss * (1.f / 128.f) + 1e-5f) * (1.f - lam_init);
    const u16* gp = g.g + qrow * 2048 + 1536 + h * 128;
    const float* dn = p.diff_norm + l_layer * 128;
    u16* op = (dry ? (u16*)g.out + (long)g.T * 1536 : g.qd) + qrow * 512 + h * 128;
#pragma unroll
    for (int d = 0; d < 4; ++d)
#pragma unroll
      for (int pr = 0; pr < 2; ++pr) {
        const int dd = d * 32 + 16 * pr;
        const u32x2 ga = *(const u32x2*)(gp + dd + 4 * lh);
        const u32x2 gb = *(const u32x2*)(gp + dd + 8 + 4 * lh);
        const float4 wa = *(const float4*)(dn + dd + 4 * lh);
        const float4 wb = *(const float4*)(dn + dd + 8 + 4 * lh);
        store_bf8_pair(op + dd, lh, O[d][8 * pr] * r * wa.x * bf_lo(ga[0]), O[d][8 * pr + 1] * r * wa.y * bf_hi(ga[0]),
                       O[d][8 * pr + 2] * r * wa.z * bf_lo(ga[1]), O[d][8 * pr + 3] * r * wa.w * bf_hi(ga[1]),
                       O[d][8 * pr + 4] * r * wb.x * bf_lo(gb[0]), O[d][8 * pr + 5] * r * wb.y * bf_hi(gb[0]),
                       O[d][8 * pr + 6] * r * wb.z * bf_lo(gb[1]), O[d][8 * pr + 7] * r * wb.w * bf_hi(gb[1]));
      }
  }
  __syncthreads();
}

DI float* dft_part(const GroupP& g, int part) { return (float*)g.cq + (size_t)part * g.B * g.Hp * 512; }
DI void dft_item(const Params& p, const GroupP& g, int item, char* smem) {
  const int tid = tid_(), lane = tid & 63, wid = __builtin_amdgcn_readfirstlane(tid >> 6);
  const int wm = wid >> 1, wn = wid & 1, lr = lane & 31, lh = lane >> 5;
  const int nb8 = g.B * 8;
  int mt = item / nb8, r = item - mt * nb8;
  int b = r >> 3, nt = (r >> 1) & 3, part = r & 1;
  int m0 = mt * 256, n0 = nt * 128;
  const int Hp = g.Hp, K2 = 2 * Hp;
  f32x16 acc[4][2];
  const u16* A = g.fm + part * Hp;
  float rsd[4];
  gemm_main<true, false>([&](int kt) { return ASrc{A + kt * 64, (long)K2}; }, m0, g.abt + ((long)b * 512 + n0) * K2 + part * Hp, K2, Hp, smem, acc, 0.f, rsd);
  float* dst = dft_part(g, part) + (size_t)b * Hp * 512;
#pragma unroll
  for (int mi = 0; mi < 4; ++mi) {
    int mm = m0 + wm * 128 + mi * 32 + lr;
    if (mm >= Hp) continue;
#pragma unroll
    for (int ni = 0; ni < 2; ++ni)
#pragma unroll
      for (int gi = 0; gi < 4; ++gi) {
        int n = n0 + wn * 64 + ni * 32 + 8 * gi + 4 * lh;
        float4 o = {acc[mi][ni][4 * gi], acc[mi][ni][4 * gi + 1], acc[mi][ni][4 * gi + 2], acc[mi][ni][4 * gi + 3]};
        *(float4*)(dst + (size_t)mm * 512 + n) = o;
      }
  }
}

DI void phase_dftfin(const GroupP& g, int vb) {
  const int tid = tid_();
  const int H = g.L >> 1, Hp = g.Hp, L = g.L, Lp = g.Lp;
  const float* P = dft_part(g, 0);
  const float* Q = dft_part(g, 1);
  const int total = g.B * (H + 1) * 128;
  for (int i = vb * NTHR + tid; i < total; i += gridDim.x * NTHR) {
    const int c = i & 127, rk = i >> 7;
    const int b = rk / (H + 1), k = rk - b * (H + 1);
    const size_t src = ((size_t)b * Hp + k) * 512 + c * 4;
    const float4 pv = *(const float4*)(P + src);
    const float4 qv = *(const float4*)(Q + src);
    const long row1 = (long)b * Lp + k;
    const u32x2 g1 = *(const u32x2*)(g.g + row1 * 2048 + c * 4);
    store_bf4(g.uf + row1 * 512 + c * 4, (pv.x + qv.x) * bf_lo(g1[0]), (pv.y + qv.y) * bf_hi(g1[0]), (pv.z + qv.z) * bf_lo(g1[1]),
              (pv.w + qv.w) * bf_hi(g1[1]));
    if (k >= 1 && k < H) {
      const long row2 = (long)b * Lp + (L - k);
      const u32x2 g2 = *(const u32x2*)(g.g + row2 * 2048 + c * 4);
      store_bf4(g.uf + row2 * 512 + c * 4, (pv.x - qv.x) * bf_lo(g2[0]), (pv.y - qv.y) * bf_hi(g2[0]), (pv.z - qv.z) * bf_lo(g2[1]),
                (pv.w - qv.w) * bf_hi(g2[1]));
    }
  }
}

DI int pad8(int n) { return (n + 7) & ~7; }

DI void phase_mix(const Params& p, int l, char* smem, int xcc) {
  const GroupP& ga = p.grp[0];
  const GroupP& gb = p.grp[1];
  int* s_item = (int*)(smem + SMEM_BYTES - 16);
  const int G = gridDim.x;
  {
    const int nDft1 = gb.B * ((gb.Hp + 255) / 256) * 8;
    const int nDft0 = ga.B * ((ga.Hp + 255) / 256) * 8;
    for (int it = blockIdx.x; it < pad8(nDft1); it += G) {
      const int tt = xcd_tile(it, nDft1);
      if (tt >= 0) dft_item(p, gb, tt, smem);
    }
    const int vb = (blockIdx.x + G - pad8(nDft1) % G) % G;
    for (int it = vb; it < pad8(nDft0); it += G) {
      const int tt = xcd_tile(it, nDft0);
      if (tt >= 0) dft_item(p, ga, tt, smem);
    }
  }
  const int nqbMa = ga.Lp / 128, nqbDa = (ga.L + 63) / 64, nqbMb = gb.Lp / 128, nqbDb = (gb.L + 63) / 64;
  const int nMa = ga.B * nqbMa, nDa = (ga.B >> 1) * nqbDa;
  const int nMb = gb.B * nqbMb, nDb = (gb.B >> 1) * nqbDb;
  const int e0 = nMa, e1 = e0 + nDa, e2 = e1 + nMb, perX = e2 + nDb;
  int* ctrb = p.ctr + l * 8;
  for (int steal = 0; steal < 8; ++steal) {
    const int q = (xcc + steal) & 7;
    for (;;) {
      if (threadIdx.x == 0) *s_item = atomicAdd(&ctrb[q], 1);
      __syncthreads();
      const int j = *s_item;
      __syncthreads();
      if (j >= perX) break;
      if (j < e0) {
        const int pl = j / nqbMa, qb = j - pl * nqbMa;
        mla_item(p, ga, (q + 8 * pl) * nqbMa + qb, smem, false);
      } else if (j < e1) {
        const int jj = j - e0;
        const int pl = jj / nqbDa, qb = jj - pl * nqbDa;
        diff_item(p, ga, l, (q + 8 * pl) * nqbDa + qb, smem, false);
      } else if (j < e2) {
        const int jj = j - e1;
        const int pl = jj / nqbMb, qb = jj - pl * nqbMb;
        mla_item(p, gb, (q + 8 * pl) * nqbMb + qb, smem, false);
      } else {
        const int jj = j - e2;
        const int pl = jj / nqbDb, qb = jj - pl * nqbDb;
        diff_item(p, gb, l, (q + 8 * pl) * nqbDb + qb, smem, false);
      }
    }
  }
}

DI void phase_outproj(const Params& p, const GroupP& g, int l, char* smem, int vb) {
  const int tid = tid_(), lane = tid & 63, wid = __builtin_amdgcn_readfirstlane(tid >> 6);
  const int wm = wid >> 1, wn = wid & 1, lr = lane & 31, lh = lane >> 5;
  const int nmt = g.T / 256;
  const u16* W = p.woT + (long)l * DM * DM;
  const int ntiles = nmt * 16;
  for (int it = vb; it < ((ntiles + 7) & ~7); it += gridDim.x) {
    const int tt = xcd_tile(it, ntiles);
    if (tt < 0) continue;
    int nt, mt;
    tile_mn(tt, nmt, 16, mt, nt);
    int m0 = mt * 256, n0 = nt * 128;
    f32x16 acc[4][2];
    const u16 *uf = g.uf, *q = g.q, *qd = g.qd;
    float rsd[4];
    gemm_main<true, false>(
        [&](int kt) {
          int k0 = kt * 64;
          if (k0 < 512) return ASrc{uf + k0, 512};
          if (k0 < 1536) { int kk = k0 - 512; return ASrc{q + (kk >> 7) * 192 + (kk & 127), 1536}; }
          return ASrc{qd + (k0 - 1536), 512};
        },
        m0, W + (long)n0 * DM, DM, DM, smem, acc, 0.f, rsd);
#pragma unroll
    for (int mi = 0; mi < 4; ++mi) {
      int m = m0 + wm * 128 + mi * 32 + lr;
      int b = m / g.Lp, t = m - b * g.Lp;
      if (t >= g.L) continue;
      if (l == 0) {
        const float* res = (t < 16) ? p.meta + t * DM : g.x + ((long)b * (g.L - 16) + (t - 16)) * DM;
        u16* dst = g.h1b + (long)m * DM;
        float ss = 0.f;
#pragma unroll
        for (int ni = 0; ni < 2; ++ni)
#pragma unroll
          for (int pr = 0; pr < 2; ++pr) {
            const int n = n0 + wn * 64 + ni * 32 + 16 * pr;
            const float4 ra = *(const float4*)(res + n + 4 * lh);
            const float4 rb = *(const float4*)(res + n + 8 + 4 * lh);
            const float a0 = ra.x + acc[mi][ni][8 * pr], a1 = ra.y + acc[mi][ni][8 * pr + 1];
            const float a2 = ra.z + acc[mi][ni][8 * pr + 2], a3 = ra.w + acc[mi][ni][8 * pr + 3];
            const float b0 = rb.x + acc[mi][ni][8 * pr + 4], b1 = rb.y + acc[mi][ni][8 * pr + 5];
            const float b2 = rb.z + acc[mi][ni][8 * pr + 6], b3 = rb.w + acc[mi][ni][8 * pr + 7];
            store_bf8_pair(dst + n, lh, a0, a1, a2, a3, b0, b1, b2, b3);
            ss += a0 * a0 + a1 * a1 + a2 * a2 + a3 * a3 + b0 * b0 + b1 * b1 + b2 * b2 + b3 * b3;
          }
        atomicAdd(p.rowsq + (size_t)4 * 50432 + g.seq0 + m, ss);
      } else {
        if (t < 16) continue;
        const u16* res = g.h1b + (long)m * DM;
        float* dst = g.out + ((long)b * (g.L - 16) + (t - 16)) * DM;
#pragma unroll
        for (int ni = 0; ni < 2; ++ni)
#pragma unroll
          for (int gi = 0; gi < 4; ++gi) {
            int n = n0 + wn * 64 + ni * 32 + 8 * gi + 4 * lh;
            u32x2 rv = *(const u32x2*)(res + n);
            float4 o = {bf_lo(rv[0]) + acc[mi][ni][4 * gi], bf_hi(rv[0]) + acc[mi][ni][4 * gi + 1],
                        bf_lo(rv[1]) + acc[mi][ni][4 * gi + 2], bf_hi(rv[1]) + acc[mi][ni][4 * gi + 3]};
            *(float4*)(dst + n) = o;
          }
      }
    }
  }
}

DI void phase_final(const Params& p) {
  const int tid = tid_(), lane = tid & 63, wid = __builtin_amdgcn_readfirstlane(tid >> 6);
  const int rows0 = p.grp[0].B * (p.grp[0].L - 16), rows1 = p.grp[1].B * (p.grp[1].L - 16);
  for (int it = blockIdx.x; it < (rows0 + rows1) / 4; it += gridDim.x) {
    int row = it * 4 + wid;
    float* ptr = (row < rows0) ? p.grp[0].out + (long)row * DM : p.grp[1].out + (long)(row - rows0) * DM;
    float4 v[8];
    float ss = 0.f;
#pragma unroll
    for (int i = 0; i < 8; ++i) {
      v[i] = *(const float4*)(ptr + (i * 64 + lane) * 4);
      ss += v[i].x * v[i].x + v[i].y * v[i].y + v[i].z * v[i].z + v[i].w * v[i].w;
    }
    ss = wave_sum(ss);
    float r = __builtin_amdgcn_rsqf(ss * (1.f / DM) + 1e-6f);
#pragma unroll
    for (int i = 0; i < 8; ++i) {
      float4 w = *(const float4*)(p.final_norm + (i * 64 + lane) * 4);
      float4 o = {v[i].x * r * w.x, v[i].y * r * w.y, v[i].z * r * w.z, v[i].w * r * w.w};
      *(float4*)(ptr + (i * 64 + lane) * 4) = o;
    }
  }
}

#define XB_TMO      128
#define XB_XCNT(j)  (256  + 64 * (j))
#define XB_XSUB(j)  (1280 + 64 * (j))
#define XB_XGEN(j)  (2304 + 64 * (j))
#define XB_TOP      3328
#define XB_TOPGEN   3392
#define XCD_BAR_WORDS 3456
#define XB_SPIN_CAP (1u << 22)
#define LAS __attribute__((address_space(3)))
DI unsigned xb_ld(unsigned* p) { return __hip_atomic_load(p, __ATOMIC_RELAXED, __HIP_MEMORY_SCOPE_AGENT); }
DI unsigned xb_add(unsigned* p, unsigned v) { return __hip_atomic_fetch_add(p, v, __ATOMIC_RELAXED, __HIP_MEMORY_SCOPE_AGENT); }
DI unsigned xb_xcc_id() { return (unsigned)__builtin_amdgcn_s_getreg((3 << 11) | 20) & 0xFu; }
#define XB_SPIN(cond, bar) do { unsigned _sp = 0; while (cond) { __builtin_amdgcn_s_sleep(1); \
    if ((++_sp & 255u) == 0u) { if (xb_ld(&(bar)[XB_TMO])) break; if (_sp > XB_SPIN_CAP) { atomicAdd(&(bar)[XB_TMO], 1u); break; } } } } while (0)
struct XcdBarrier { unsigned* bar; unsigned x; volatile LAS unsigned* st; };
DI XcdBarrier xcd_barrier_post(unsigned* bar, volatile LAS unsigned* st) {
  XcdBarrier b; b.bar = bar; b.x = xb_xcc_id(); b.st = st;
  if (threadIdx.x == 0) (void)xb_add(&bar[XB_XCNT(b.x)], 1u);
  return b;
}
DI void xcd_barrier_complete(unsigned* bar, unsigned x, unsigned& nloc, unsigned& nx) {
  const unsigned G = gridDim.x * gridDim.y * gridDim.z;
  unsigned sum, cnt, mine, sp = 0u;
  for (;;) {
    sum = 0u; cnt = 0u; mine = 0u;
#pragma unroll
    for (unsigned j = 0; j < 16; ++j) { const unsigned c = xb_ld(&bar[XB_XCNT(j)]); sum += c; cnt += (c > 0u) ? 1u : 0u; mine = (j == x) ? c : mine; }
    if (sum == G) break;
    __builtin_amdgcn_s_sleep(1);
    if ((++sp & 255u) == 0u) { if (xb_ld(&bar[XB_TMO])) break; if (sp > XB_SPIN_CAP) { atomicAdd(&bar[XB_TMO], 1u); break; } }
  }
  nloc = mine > 0u ? mine : 1u; nx = cnt > 0u ? cnt : 1u;
}
DI void xcd_barrier(const XcdBarrier& b) {
  asm volatile("s_waitcnt vmcnt(0)" ::: "memory");
  __syncthreads();
  if (threadIdx.x == 0) {
    unsigned* bar = b.bar;
    __builtin_amdgcn_s_waitcnt(0);
    unsigned nloc = b.st[0], nx = b.st[1];
    if (nloc == 0u) { xcd_barrier_complete(bar, b.x, nloc, nx); b.st[0] = nloc; b.st[1] = nx; }
    const unsigned old = xb_add(&bar[XB_XSUB(b.x)], 1u);
    const unsigned gen = old / nloc;
    if (old + 1u == (gen + 1u) * nloc) {
      __builtin_amdgcn_fence(__ATOMIC_RELEASE, "agent");
      asm volatile("s_waitcnt vmcnt(0)" ::: "memory");
      const unsigned og = xb_add(&bar[XB_TOP], 1u);
      const unsigned tg = og / nx;
      if (og + 1u == (tg + 1u) * nx) xb_add(&bar[XB_TOPGEN], 1u);
      else XB_SPIN(xb_ld(&bar[XB_TOPGEN]) == tg, bar);
      __builtin_amdgcn_fence(__ATOMIC_ACQUIRE, "agent");
      xb_add(&bar[XB_XGEN(b.x)], 1u);
      asm volatile("s_waitcnt vmcnt(0)" ::: "memory");
    } else {
      XB_SPIN(xb_ld(&bar[XB_XGEN(b.x)]) == gen, bar);
      __builtin_amdgcn_fence(__ATOMIC_ACQUIRE, "agent");
      asm volatile("s_waitcnt vmcnt(0)" ::: "memory");
    }
  }
  __syncthreads();
}

constexpr int NPHASE = 12;

__global__ void __launch_bounds__(NTHR, 2) mega(Params p_unused, int ph_lo, int ph_hi) {
  __shared__ __attribute__((aligned(16))) char smem[SMEM_BYTES];
  __shared__ uint4 xb_words;
  if (threadIdx.x == 0) xb_words = make_uint4(0u, 0u, 0u, 0u);
  __syncthreads();
  {
    typedef const __attribute__((address_space(4))) Params* CPP0;
    CPP0 kp0 = (CPP0)__builtin_amdgcn_kernarg_segment_ptr();
    (void)xcd_barrier_post(kp0->bar, (volatile LAS unsigned*)&xb_words);
  }
  for (int ph = ph_lo; ph < ph_hi; ++ph) {
    typedef const __attribute__((address_space(4))) char* CP;
    CP kq = (CP)__builtin_amdgcn_kernarg_segment_ptr();
    asm volatile("" : "+s"(kq));
    typedef const __attribute__((address_space(4))) Params* CPP;
    CPP kp = (CPP)kq;
    Params p;
    p.grp[0].x = kp->grp[0].x;
    p.grp[0].out = kp->grp[0].out;
    p.grp[0].B = kp->grp[0].B;
    p.grp[0].L = kp->grp[0].L;
    p.grp[0].Lp = kp->grp[0].Lp;
    p.grp[0].T = kp->grp[0].T;
    p.grp[0].seq0 = kp->grp[0].seq0;
    p.grp[0].Hp = kp->grp[0].Hp;
    p.grp[0].xb = kp->grp[0].xb;
    p.grp[0].uf = kp->grp[0].uf;
    p.grp[0].cq = kp->grp[0].cq;
    p.grp[0].ckv = kp->grp[0].ckv;
    p.grp[0].kr = kp->grp[0].kr;
    p.grp[0].qd = kp->grp[0].qd;
    p.grp[0].kd = kp->grp[0].kd;
    p.grp[0].vdt = kp->grp[0].vdt;
    p.grp[0].g = kp->grp[0].g;
    p.grp[0].q = kp->grp[0].q;
    p.grp[0].abt = kp->grp[0].abt;
    p.grp[0].fm = kp->grp[0].fm;
    p.grp[0].h1b = kp->grp[0].h1b;
    p.grp[1].x = kp->grp[1].x;
    p.grp[1].out = kp->grp[1].out;
    p.grp[1].B = kp->grp[1].B;
    p.grp[1].L = kp->grp[1].L;
    p.grp[1].Lp = kp->grp[1].Lp;
    p.grp[1].T = kp->grp[1].T;
    p.grp[1].seq0 = kp->grp[1].seq0;
    p.grp[1].Hp = kp->grp[1].Hp;
    p.grp[1].xb = kp->grp[1].xb;
    p.grp[1].uf = kp->grp[1].uf;
    p.grp[1].cq = kp->grp[1].cq;
    p.grp[1].ckv = kp->grp[1].ckv;
    p.grp[1].kr = kp->grp[1].kr;
    p.grp[1].qd = kp->grp[1].qd;
    p.grp[1].kd = kp->grp[1].kd;
    p.grp[1].vdt = kp->grp[1].vdt;
    p.grp[1].g = kp->grp[1].g;
    p.grp[1].q = kp->grp[1].q;
    p.grp[1].abt = kp->grp[1].abt;
    p.grp[1].fm = kp->grp[1].fm;
    p.grp[1].h1b = kp->grp[1].h1b;
    p.meta = kp->meta;
    p.rel_bias = kp->rel_bias;
    p.final_norm = kp->final_norm;
    p.norm_w = kp->norm_w;
    p.w_in = kp->w_in;
    p.w_fmix = kp->w_fmix;
    p.q_norm = kp->q_norm;
    p.w_uq = kp->w_uq;
    p.kv_norm = kp->kv_norm;
    p.w_ukv = kp->w_ukv;
    p.lq1 = kp->lq1;
    p.lk1 = kp->lk1;
    p.lq2 = kp->lq2;
    p.lk2 = kp->lk2;
    p.diff_norm = kp->diff_norm;
    p.w_o = kp->w_o;
    p.winT = kp->winT;
    p.wuqT = kp->wuqT;
    p.wukvT = kp->wukvT;
    p.woT = kp->woT;
    p.mfT = kp->mfT;
    p.rope = kp->rope;
    p.lam = kp->lam;
    p.hmeta = kp->hmeta;
    p.ctr = kp->ctr;
    p.bar = kp->bar;
    p.rowsq = kp->rowsq;
    if (ph == 11) {
      phase_final(p);
    } else {
      const int l = ph >= 6 ? 1 : 0, st = ph >= 6 ? ph - 5 : ph;
      const GroupP& g0 = p.grp[0];
      const GroupP& g1 = p.grp[1];
      const int G = gridDim.x, bid = blockIdx.x;
      if (st == 0) {
        if (ph == 0) phase_wprep(p, &kp->rope_hi[0], &kp->rope_lo[0], smem, 0);
        phase_rowprep(p, g1, l, bid);
        phase_rowprep(p, g0, l, (bid + G - (g1.T / 4) % G) % G);
      } else if (st == 1) {
        phase_inproj(p, g1, l, smem, bid);
        phase_inproj(p, g0, l, smem, (bid + G - pad8((g1.T / 256) * 43) % G) % G);
        if (l == 0) {
          phase_wprep(p, &kp->rope_hi[0], &kp->rope_lo[0], smem, 1);
          phase_dftfill(g1, G - 1 - bid);
          phase_dftfill(g0, G - 1 - bid);
        }
      } else if (st == 2) {
        phase_upproj(p, g1, l, smem, bid);
        phase_upproj(p, g0, l, smem, (bid + G - pad8((g1.T / 256) * 28) % G) % G);
      } else if (st == 3) {
        phase_mix(p, l, smem, (int)(xb_xcc_id() & 7u));
      } else if (st == 4) {
        phase_dftfin(g1, bid);
        phase_dftfin(g0, bid);
      } else {
        phase_outproj(p, g1, l, smem, bid);
        phase_outproj(p, g0, l, smem, (bid + G - pad8((g1.T / 256) * 16) % G) % G);
      }
    }
    if (ph + 1 < ph_hi) {
      XcdBarrier xb;
      xb.bar = p.bar; xb.x = xb_xcc_id(); xb.st = (volatile LAS unsigned*)&xb_words;
      xcd_barrier(xb);
    }
    if (ph_hi == 0x7fffffff) cg::this_grid().sync();
  }
}

extern "C" void kernel_launch(void* const* d_in, const int* in_sizes, int n_in, void* d_out, int out_size, void* d_ws,
                              size_t ws_size, hipStream_t stream) {
  Params p;
  memset(&p, 0, sizeof(p));
  const float* x_prompt = (const float*)d_in[0];
  const float* x_sample = (const float*)d_in[1];
  p.meta = (const float*)d_in[2];
  p.rel_bias = (const float*)d_in[3];
  p.final_norm = (const float*)d_in[4];
  p.norm_w = (const float*)d_in[5];
  p.w_in = (const float*)d_in[6];
  p.w_fmix = (const float*)d_in[7];
  p.q_norm = (const float*)d_in[8];
  p.w_uq = (const float*)d_in[9];
  p.kv_norm = (const float*)d_in[10];
  p.w_ukv = (const float*)d_in[11];
  p.lq1 = (const float*)d_in[12];
  p.lk1 = (const float*)d_in[13];
  p.lq2 = (const float*)d_in[14];
  p.lk2 = (const float*)d_in[15];
  p.diff_norm = (const float*)d_in[16];
  p.w_o = (const float*)d_in[17];

  for (int c = 0; c < 32; ++c) {
    double inv = pow(10000.0, -(double)c / 32.0) / (2.0 * 3.14159265358979323846);
    float hi = (float)inv;
    p.rope_hi[c] = hi;
    p.rope_lo[c] = (float)(inv - (double)hi);
  }
  char* ws = (char*)d_ws;
  size_t off = 0;
  auto take = [&](size_t bytes) { char* r = ws + off; off += (bytes + 255) & ~(size_t)255; return r; };
  p.winT = (u16*)take((size_t)2 * INWP * DM * 2);
  p.wuqT = (u16*)take((size_t)2 * 1536 * 768 * 2);
  p.wukvT = (u16*)take((size_t)2 * 2048 * 512 * 2);
  p.woT = (u16*)take((size_t)2 * DM * DM * 2);
  p.mfT = (u16*)take((size_t)2 * 4 * 256 * 128 * 2);
  p.rope = (float2*)take((size_t)8320 * 32 * 8);
  p.lam = (float*)take(256);
  p.hmeta = (float*)take((size_t)10 * 16 * DM * 4);
  p.ctr = (int*)take(1024);
  p.bar = (unsigned*)take(XCD_BAR_WORDS * 4);
  p.rowsq = (float*)take((size_t)5 * 50432 * 4);
  char* os = (char*)d_out;
  size_t ooff = 0;
  auto otake = [&](size_t bytes) { char* r = os + ooff; ooff += (bytes + 255) & ~(size_t)255; return r; };
  for (int gi = 0; gi < 2; ++gi) {
    GroupP& g = p.grp[gi];
    g.B = gi == 0 ? 2 : 8;
    int S = gi == 0 ? 8192 : 4096;
    g.L = S + 16;
    g.Lp = (g.L + 127) / 128 * 128;
    g.T = g.B * g.Lp;
    g.Hp = (g.L / 2 + 1 + 127) / 128 * 128;
    g.seq0 = gi == 0 ? 0 : 16640;
    g.x = gi == 0 ? x_prompt : x_sample;
    g.out = (float*)d_out + (gi == 0 ? 0 : (size_t)2 * 8192 * DM);
    size_t T = g.T;
    g.xb = (u16*)otake(T * 2048 * 2);
    g.cq = (u16*)otake(T * 768 * 2);
    g.ckv = (u16*)otake(T * 512 * 2);
    g.kr = (u16*)otake(T * 64 * 2);
    g.kd = (u16*)otake(T * 512 * 2);
    g.uf = (u16*)take(T * 512 * 2);
    g.qd = (u16*)take(T * 512 * 2);
    g.vdt = (u16*)take(T * 512 * 2);
    g.g = (u16*)take(T * 2048 * 2);
    g.q = (u16*)take(T * 1536 * 2);
    g.h1b = (u16*)take(T * 2048 * 2);
    g.abt = (u16*)take((size_t)g.B * 512 * 2 * g.Hp * 2);
    g.fm = (u16*)take((size_t)((g.Hp + 255) / 256 * 256) * 2 * g.Hp * 2);
  }
  const size_t need = off;
  if (need > ws_size || ooff > (size_t)out_size * 4) {
    fprintf(stderr, "workspace too small: need %zu have %zu (out scratch %zu of %zu)\n", need, ws_size, ooff, (size_t)out_size * 4);
    return;
  }

  static int grid_blocks = 0;
  if (!grid_blocks) {
    int dev = 0, cus = 0, per_cu = 0;
    hipGetDevice(&dev);
    hipDeviceGetAttribute(&cus, hipDeviceAttributeMultiprocessorCount, dev);
    hipOccupancyMaxActiveBlocksPerMultiprocessor(&per_cu, mega, NTHR, 0);
    if (per_cu < 1) per_cu = 1;
    if (per_cu > 2) per_cu = 2;
    grid_blocks = cus * per_cu;
  }
  hipMemsetAsync(p.bar, 0, XCD_BAR_WORDS * 4, stream);
#if COOP
  int lo = 0, hi = NPHASE;
  void* args[] = {&p, &lo, &hi};
  hipError_t e = hipLaunchCooperativeKernel((void*)mega, dim3(grid_blocks), dim3(NTHR), args, 0, stream);
  if (e != hipSuccess) fprintf(stderr, "cooperative launch failed: %s (grid %d)\n", hipGetErrorString(e), grid_blocks);
#else
  for (int ph = 0; ph < NPHASE; ++ph) mega<<<grid_blocks, NTHR, 0, stream>>>(p, ph, ph + 1);
#endif
}
```

```cpp
#include <hip/hip_runtime.h>
#include <hip/hip_cooperative_groups.h>
#include <cstdio>
#include <cstring>
#include <cmath>
namespace cg = cooperative_groups;

#ifndef COOP
#define COOP 1
#endif

typedef unsigned short u16;
using bf16x8 = __attribute__((ext_vector_type(8))) short;
using f32x16 = __attribute__((ext_vector_type(16))) float;
using u32x4 = __attribute__((ext_vector_type(4))) unsigned;
using u32x2 = __attribute__((ext_vector_type(2))) unsigned;
#define DI __device__ __forceinline__
#define MFMA(a, b, c) __builtin_amdgcn_mfma_f32_32x32x16_bf16((a), (b), (c), 0, 0, 0)

constexpr int DM = 2048;
constexpr int INW = 5440;
constexpr int INWP = 5504;
constexpr float LOG2E = 1.4426950408889634f;
constexpr int NTHR = 256;
constexpr int SMEM_BYTES = 256 * 144 + 128 * 144 + 1024;

struct GroupP {
  const float* x;
  float* out;
  int B, L, Lp, T;
  int seq0, Hp;
  u16 *xb, *uf, *cq, *ckv, *kr, *qd, *kd, *vdt, *g, *q, *abt, *fm;
  u16* h1b;
};
struct Params {
  GroupP grp[2];
  const float *meta, *rel_bias, *final_norm, *norm_w, *w_in, *w_fmix, *q_norm, *w_uq, *kv_norm, *w_ukv;
  const float *lq1, *lk1, *lq2, *lk2, *diff_norm, *w_o;
  u16 *winT, *wuqT, *wukvT, *woT, *mfT;
  float2* rope;
  float* lam;
  float* hmeta;
  int* ctr;
  unsigned* bar;
  float* rowsq;
  float rope_hi[32], rope_lo[32];
};

DI unsigned pk2(float lo, float hi) {
  typedef __bf16 bf2 __attribute__((ext_vector_type(2)));
  typedef float f2 __attribute__((ext_vector_type(2)));
  f2 v = {lo, hi};
  return __builtin_bit_cast(unsigned, __builtin_convertvector(v, bf2));
}
DI u16 bf1(float x) { return (u16)(pk2(x, 0.f) & 0xffffu); }
DI float bf_lo(unsigned u) { return __uint_as_float(u << 16); }
DI float bf_hi(unsigned u) { return __uint_as_float(u & 0xffff0000u); }
DI int tid_() { int t = threadIdx.x; asm volatile("" : "+v"(t)); return t; }
DI int crow(int i, int h) { return (i & 3) + 8 * (i >> 2) + 4 * h; }
DI float wave_sum(float v) {
#pragma unroll
  for (int o = 32; o >= 1; o >>= 1) v += __shfl_xor(v, o, 64);
  return v;
}

struct ASrc { const u16* p; long ld; };

DI float dot2bf(unsigned a, float c) {
  typedef __bf16 bf2 __attribute__((ext_vector_type(2)));
  bf2 x = __builtin_bit_cast(bf2, a);
  return __builtin_amdgcn_fdot2_f32_bf16(x, x, c, false);
}

template <bool SWAP, bool SSQ, class AF>
DI void gemm_main(AF asrc, int m0, const u16* __restrict__ Bw, int ldb, int K, char* smem,
                  f32x16 (&acc)[4][2], float ssq_eps, float (&rs)[4]) {
  const int tid = tid_(), lane = tid & 63, wid = __builtin_amdgcn_readfirstlane(tid >> 6);
  const int wm = wid >> 1, wn = wid & 1, lr = lane & 31, lh = lane >> 5;
  char* sA = smem;
  char* sB = smem + 256 * 144;
  const int srow = tid >> 3, skc = tid & 7;
  const unsigned lds_st = srow * 144 + skc * 16;
  const unsigned voffB = (unsigned)(srow * ldb * 2 + skc * 16);
  u32x4 ra[8], rb[4];
#pragma unroll
  for (int i = 0; i < 4; ++i) rs[i] = 0.f;
#pragma unroll
  for (int mi = 0; mi < 4; ++mi)
#pragma unroll
    for (int ni = 0; ni < 2; ++ni)
#pragma unroll
      for (int i = 0; i < 16; ++i) acc[mi][ni][i] = 0.f;

  auto gload = [&](int kt) {
    ASrc s = asrc(kt);
    const unsigned voffA = (unsigned)(srow * (int)s.ld * 2 + skc * 16);
    const char* ua = (const char*)s.p + (long)m0 * s.ld * 2;
#pragma unroll
    for (int i = 0; i < 8; ++i) ra[i] = *(const u32x4*)(ua + (long)(32 * i) * s.ld * 2 + voffA);
    const char* ub = (const char*)Bw + (long)kt * 128;
#pragma unroll
    for (int i = 0; i < 4; ++i) rb[i] = *(const u32x4*)(ub + (long)(32 * i) * ldb * 2 + voffB);
  };
  auto sstore = [&]() {
#pragma unroll
    for (int i = 0; i < 8; ++i) *(u32x4*)(sA + lds_st + i * (32 * 144)) = ra[i];
#pragma unroll
    for (int i = 0; i < 4; ++i) *(u32x4*)(sB + lds_st + i * (32 * 144)) = rb[i];
  };

  const int nkt = K >> 6;
  const char* pA = sA + (wm * 128 + lr) * 144 + lh * 16;
  const char* pB = sB + (wn * 64 + lr) * 144 + lh * 16;
  gload(0);
  sstore();
  __syncthreads();
  for (int kt = 0; kt < nkt; ++kt) {
    if (kt + 1 < nkt) gload(kt + 1);
    __builtin_amdgcn_sched_barrier(0);
    {
      bf16x8 ar[3], br[2][2];
      ar[0] = *(const bf16x8*)(pA);
      ar[1] = *(const bf16x8*)(pA + 32 * 144);
      br[0][0] = *(const bf16x8*)(pB);
      br[0][1] = *(const bf16x8*)(pB + 32 * 144);
      __builtin_amdgcn_sched_group_barrier(0x100, 4, 0);
#pragma unroll
      for (int t = 0; t < 16; ++t) {
        const int ks = t >> 2, mi = t & 3;
        if (t + 2 < 16) {
          ar[(t + 2) % 3] = *(const bf16x8*)(pA + ((t + 2) & 3) * (32 * 144) + ((t + 2) >> 2) * 32);
          if (mi == 1 && ks + 1 < 4) {
            br[(ks + 1) & 1][0] = *(const bf16x8*)(pB + (ks + 1) * 32);
            br[(ks + 1) & 1][1] = *(const bf16x8*)(pB + 32 * 144 + (ks + 1) * 32);
            __builtin_amdgcn_sched_group_barrier(0x100, 3, 0);
          } else {
            __builtin_amdgcn_sched_group_barrier(0x100, 1, 0);
          }
        }
        acc[mi][0] = SWAP ? MFMA(br[ks & 1][0], ar[t % 3], acc[mi][0]) : MFMA(ar[t % 3], br[ks & 1][0], acc[mi][0]);
        acc[mi][1] = SWAP ? MFMA(br[ks & 1][1], ar[t % 3], acc[mi][1]) : MFMA(ar[t % 3], br[ks & 1][1], acc[mi][1]);
        __builtin_amdgcn_sched_group_barrier(0x008, 2, 0);
        if (SSQ) {
          u32x4 u = __builtin_bit_cast(u32x4, ar[t % 3]);
#pragma unroll
          for (int j = 0; j < 4; ++j) rs[mi] = dot2bf(u[j], rs[mi]);
        }
      }
    }
    __syncthreads();
    if (kt + 1 < nkt) sstore();
    __syncthreads();
  }
  if (SSQ) {
#pragma unroll
    for (int mi = 0; mi < 4; ++mi) {
      float v = rs[mi] + __shfl_xor(rs[mi], 32, 64);
      rs[mi] = __builtin_amdgcn_rsqf(v / (float)K + ssq_eps);
    }
  }
}

DI int xcd_tile(int it, int total) {
  const int per = (total + 7) >> 3;
  const int j = it >> 3;
  const int t = (it & 7) * per + j;
  return (j < per && t < total) ? t : -1;
}
constexpr int TGM = 4;
DI void tile_mn(int t, int nmt, int nnt, int& mt, int& nt) {
  const int gs = TGM * nnt;
  const int mg = t / gs, r = t - mg * gs;
  const int rem = nmt - mg * TGM;
  const int gsz = rem < TGM ? rem : TGM;
  nt = r / gsz;
  mt = mg * TGM + (r - nt * gsz);
}

DI float silu(float x) { return x * __builtin_amdgcn_rcpf(1.f + __builtin_amdgcn_exp2f(-x * LOG2E)); }

DI void store_bf8_pair(u16* p16, int lh, float a0, float a1, float a2, float a3, float b0, float b1, float b2, float b3) {
  const unsigned pa0 = pk2(a0, a1), pa1 = pk2(a2, a3), pb0 = pk2(b0, b1), pb1 = pk2(b2, b3);
  auto r0 = __builtin_amdgcn_permlane32_swap(pa0, pb0, false, false);
  auto r1 = __builtin_amdgcn_permlane32_swap(pa1, pb1, false, false);
  u32x4 w = {r0[0], r1[0], r0[1], r1[1]};
  *(u32x4*)(p16 + 8 * lh) = w;
}

DI void load_bf8_pair(const u16* p16, int lh, u32x2& ga, u32x2& gb) {
  const u32x4 w = *(const u32x4*)(p16 + 8 * lh);
  auto r0 = __builtin_amdgcn_permlane32_swap(w[0], w[2], false, false);
  auto r1 = __builtin_amdgcn_permlane32_swap(w[1], w[3], false, false);
  ga[0] = r0[0]; ga[1] = r1[0];
  gb[0] = r0[1]; gb[1] = r1[1];
}

DI void store_bf4(u16* dst, float a, float b, float c, float d) {
  u32x2 v;
  v[0] = pk2(a, b);
  v[1] = pk2(c, d);
  *(u32x2*)dst = v;
}

DI void wprep_item(const float* __restrict__ src, u16* __restrict__ dst, int K, int N, const float* __restrict__ rowscale,
                   float cs_val, int cs_lo, int cs_hi, int kt, int nt, char* smem) {
  float* t = (float*)smem;
  const int tid = tid_();
#pragma unroll
  for (int i = 0; i < 16; ++i) {
    int k = i * 4 + (tid >> 6), n = tid & 63;
    int gk = kt * 64 + k, gn = nt * 64 + n;
    float v = 0.f;
    if (gn < N) {
      v = src[(long)gk * N + gn];
      if (rowscale) v *= rowscale[gk];
      if (gn >= cs_lo && gn < cs_hi) v *= cs_val;
    }
    t[k * 65 + n] = v;
  }
  __syncthreads();
#pragma unroll
  for (int i = 0; i < 16; ++i) {
    int n = i * 4 + (tid >> 6), k = tid & 63;
    dst[(long)(nt * 64 + n) * K + kt * 64 + k] = bf1(t[k * 65 + n]);
  }
  __syncthreads();
}

typedef const __attribute__((address_space(4))) float* CF;
DI void phase_wprep(const Params& p, CF rope_hi, CF rope_lo, char* smem, int part) {
  const int tid = tid_();
  const int nWin = 32 * 86, nWuq = 12 * 24, nWukv = 8 * 32, nWo = 32 * 32;
  const int perL = nWin + nWuq + nWukv + nWo;
  for (int it = blockIdx.x; it < 2 * perL; it += gridDim.x) {
    int l = it / perL, r = it % perL;
    if (((l == 0 && r < nWin) ? 0 : 1) != part) continue;
    if (r < nWin) {
      wprep_item(p.w_in + (long)l * DM * INW, p.winT + (long)l * INWP * DM, DM, INW, p.norm_w + l * DM,
                 0.125f * LOG2E, 1856, 2368, r / 86, r % 86, smem);
    } else if ((r -= nWin) < nWuq) {
      wprep_item(p.w_uq + (long)l * 768 * 1536, p.wuqT + (long)l * 1536 * 768, 768, 1536, p.q_norm + l * 768,
                 0.07216878364870322f * LOG2E, 0, 1536, r / 24, r % 24, smem);
    } else if ((r -= nWuq) < nWukv) {
      wprep_item(p.w_ukv + (long)l * 512 * 2048, p.wukvT + (long)l * 2048 * 512, 512, 2048, p.kv_norm + l * 512,
                 1.f, 0, 0, r / 32, r % 32, smem);
    } else {
      r -= nWukv;
      wprep_item(p.w_o + (long)l * DM * DM, p.woT + (long)l * DM * DM, DM, DM, nullptr, 1.f, 0, 0, r / 32, r % 32, smem);
    }
  }
  for (int it = blockIdx.x; it < (part == 1 ? 1024 : 0); it += gridDim.x) {
    int o = it * 256 + tid;
    int c = o & 127, n = (o >> 7) & 255, gg = (o >> 15) & 3, l = o >> 17;
    int d = n & 127, part = n >> 7;
    const float* W = p.w_fmix + (long)(l * 4 + gg) * 128 * 128;
    float s = 0.f;
    for (int cp = 0; cp < 128; ++cp) {
      float fr = (float)((c * cp) & 127) * (1.f / 128.f);
      float tr = part ? __builtin_amdgcn_sinf(fr) : __builtin_amdgcn_cosf(fr);
      s += tr * W[cp * 128 + d];
    }
    p.mfT[o] = bf1(s * 0.08838834764831845f);
  }
  for (int it = blockIdx.x; it < (part == 0 ? (8320 * 32) / 256 : 0); it += gridDim.x) {
    int o = it * 256 + tid;
    int c = o & 31, t = o >> 5;
    float tf = (float)t, hi = rope_hi[c], lo = rope_lo[c];
    float pr = tf * hi;
    float er = fmaf(tf, hi, -pr);
    float fr = (pr - floorf(pr)) + (er + tf * lo);
    p.rope[o] = make_float2(__builtin_amdgcn_cosf(fr), __builtin_amdgcn_sinf(fr));
  }
  if (part == 0 && blockIdx.x == 0 && tid < 128) p.ctr[tid] = 0;
  if (part == 0) {
    for (int i = blockIdx.x * NTHR + tid; i < 5 * 50432; i += gridDim.x * NTHR) p.rowsq[i] = 0.f;
    for (int gi = 0; gi < 2; ++gi) {
      const GroupP& g = p.grp[gi];
      const int npad = g.Lp - g.L;
      const int total = g.B * npad * (DM / 8);
      for (int i = blockIdx.x * NTHR + tid; i < total; i += gridDim.x * NTHR) {
        const int c = i % (DM / 8), rr = i / (DM / 8);
        const int b = rr / npad, t = g.L + (rr - b * npad);
        unsigned zz = 0u; asm volatile("" : "+v"(zz)); u32x4 z = {zz, zz, zz, zz};
        *(u32x4*)(g.h1b + ((long)(b * g.Lp + t)) * DM + c * 8) = z;
      }
    }
  }
  if (part == 1 && blockIdx.x == 0 && tid < 2) {
    int l = tid;
    float a = 0.f, b = 0.f;
    for (int i = 0; i < 64; ++i) {
      a += p.lq1[l * 64 + i] * p.lk1[l * 64 + i];
      b += p.lq2[l * 64 + i] * p.lk2[l * 64 + i];
    }
    float lam_init = l ? 0.35550906759f : 0.2f;
    p.lam[l] = __builtin_amdgcn_exp2f(a * LOG2E) - __builtin_amdgcn_exp2f(b * LOG2E) + lam_init;
  }
}

DI void phase_rowprep(const Params& p, const GroupP& g, int l, int vb) {
  const int tid = tid_(), lane = tid & 63, wid = __builtin_amdgcn_readfirstlane(tid >> 6);
  for (int it = vb; it < g.T / 4; it += gridDim.x) {
    int row = it * 4 + wid;
    int b = row / g.Lp, t = row - b * g.Lp;
    u16* dst = g.xb + (long)row * DM;
    if (t >= g.L) {
      unsigned zz = 0u; asm volatile("" : "+v"(zz)); u32x4 z = {zz, zz, zz, zz};
#pragma unroll
      for (int i = 0; i < 4; ++i) *(u32x4*)(dst + (i * 64 + lane) * 8) = z;
      continue;
    }
    if (l == 0) {
      const float* src = (t < 16) ? p.meta + t * DM : g.x + ((long)b * (g.L - 16) + (t - 16)) * DM;
      float4 v[8];
      float ss = 0.f;
#pragma unroll
      for (int i = 0; i < 8; ++i) {
        v[i] = *(const float4*)(src + (i * 64 + lane) * 4);
        ss += v[i].x * v[i].x + v[i].y * v[i].y + v[i].z * v[i].z + v[i].w * v[i].w;
      }
      ss = wave_sum(ss);
      float r = __builtin_amdgcn_rsqf(ss * (1.f / DM) + 1e-6f);
#pragma unroll
      for (int i = 0; i < 8; ++i) store_bf4(dst + (i * 64 + lane) * 4, v[i].x * r, v[i].y * r, v[i].z * r, v[i].w * r);
    } else {
      const u16* src = g.h1b + (long)row * DM;
      u32x4 v[4];
      float ss = 0.f;
#pragma unroll
      for (int i = 0; i < 4; ++i) {
        v[i] = *(const u32x4*)(src + (i * 64 + lane) * 8);
#pragma unroll
        for (int j = 0; j < 4; ++j) { float a = bf_lo(v[i][j]), c = bf_hi(v[i][j]); ss += a * a + c * c; }
      }
      ss = wave_sum(ss);
      float r = __builtin_amdgcn_rsqf(ss * (1.f / DM) + 1e-6f);
#pragma unroll
      for (int i = 0; i < 4; ++i) {
        u32x4 o;
#pragma unroll
        for (int j = 0; j < 4; ++j) o[j] = pk2(bf_lo(v[i][j]) * r, bf_hi(v[i][j]) * r);
        *(u32x4*)(dst + (i * 64 + lane) * 8) = o;
      }
    }
  }
}

DI void phase_dftfill(const GroupP& g, int vb) {
  const int tid = tid_();
  const int L = g.L, Lp = g.Lp, Hp = g.Hp, H = L >> 1;
  const float invL = 1.f / (float)L, nrm = 1.f / sqrtf((float)L);
  const int nch = (2 * Hp) / 8;
  const int krows = (Hp + 255) / 256 * 256;
  for (int k = vb; k < krows; k += gridDim.x) {
    u16* rowp = g.fm + (long)k * (2 * Hp);
    for (int ch = tid; ch < nch; ch += NTHR) {
      int kk0 = ch * 8;
      int part = kk0 >= Hp;
      int s0 = kk0 - part * Hp;
      float v[8];
      if (k > H) {
#pragma unroll
        for (int j = 0; j < 8; ++j) v[j] = 0.f;
      } else {
        unsigned prod = (unsigned)k * (unsigned)s0;
        int jj = (L == 8208) ? (int)(prod % 8208u) : (int)(prod % 4112u);
#pragma unroll
        for (int j = 0; j < 8; ++j) {
          float fr = (float)jj * invL;
          float tr = part ? -__builtin_amdgcn_sinf(fr) : __builtin_amdgcn_cosf(fr);
          v[j] = (s0 + j <= H) ? tr * nrm : 0.f;
          jj += k;
          if (jj >= L) jj -= L;
        }
      }
      u32x4 o;
      o[0] = pk2(v[0], v[1]); o[1] = pk2(v[2], v[3]); o[2] = pk2(v[4], v[5]); o[3] = pk2(v[6], v[7]);
      *(u32x4*)(rowp + kk0) = o;
    }
  }
}

DI void rope_store(const f32x16& a0, const f32x16& a1, const float2* __restrict__ ropet, u16* dst, int lh) {
#pragma unroll
  for (int pr = 0; pr < 2; ++pr) {
    float o1[2][4], o2[2][4];
#pragma unroll
    for (int e = 0; e < 2; ++e) {
      const int gi = 2 * pr + e;
      const int c0 = 8 * gi + 4 * lh;
      float4 t01 = *(const float4*)(ropet + c0);
      float4 t23 = *(const float4*)(ropet + c0 + 2);
      float cs[4] = {t01.x, t01.z, t23.x, t23.z};
      float sn[4] = {t01.y, t01.w, t23.y, t23.w};
#pragma unroll
      for (int j = 0; j < 4; ++j) {
        float x1 = a0[4 * gi + j], x2 = a1[4 * gi + j];
        o1[e][j] = x1 * cs[j] - x2 * sn[j];
        o2[e][j] = x2 * cs[j] + x1 * sn[j];
      }
    }
    store_bf8_pair(dst + 16 * pr, lh, o1[0][0], o1[0][1], o1[0][2], o1[0][3], o1[1][0], o1[1][1], o1[1][2], o1[1][3]);
    store_bf8_pair(dst + 32 + 16 * pr, lh, o2[0][0], o2[0][1], o2[0][2], o2[0][3], o2[1][0], o2[1][1], o2[1][2], o2[1][3]);
  }
}

DI void phase_inproj(const Params& p, const GroupP& g, int l, char* smem, int vb) {
  const int tid = tid_(), lane = tid & 63, wid = __builtin_amdgcn_readfirstlane(tid >> 6);
  const int wm = wid >> 1, wn = wid & 1, lr = lane & 31, lh = lane >> 5;
  const int nmt = g.T / 256;
  const u16* W = p.winT + (long)l * INWP * DM;
  const int ntiles = nmt * 43;
  for (int it = vb; it < ((ntiles + 7) & ~7); it += gridDim.x) {
    const int tt = xcd_tile(it, ntiles);
    if (tt < 0) continue;
    int nt, mt;
    tile_mn(tt, nmt, 43, mt, nt);
    int m0 = mt * 256, n0 = nt * 128;
    f32x16 acc[4][2];
    const u16* xb = (l == 0) ? g.xb : g.h1b;
    float rsd[4];
    gemm_main<true, false>([&](int kt) { return ASrc{xb + kt * 64, DM}; }, m0, W + (long)n0 * DM, DM, DM, smem, acc, 0.f, rsd);
    const int nw0 = n0 + wn * 64;
    if (nw0 >= INW) continue;
    if (l == 1) {
      const float* sq = p.rowsq + (size_t)4 * 50432 + g.seq0 + m0 + wm * 128 + lr;
#pragma unroll
      for (int mi = 0; mi < 4; ++mi) {
        const float r = __builtin_amdgcn_rsqf(sq[mi * 32] * (1.f / DM) + 1e-6f);
#pragma unroll
        for (int ni = 0; ni < 2; ++ni)
#pragma unroll
          for (int i = 0; i < 16; ++i) acc[mi][ni][i] *= r;
      }
    }
#pragma unroll
    for (int mi = 0; mi < 4; ++mi) {
      int m = m0 + wm * 128 + mi * 32 + lr;
      int b = m / g.Lp, t = m - b * g.Lp;
      if (nw0 == 1792) {
        rope_store(acc[mi][0], acc[mi][1], p.rope + t * 32, g.kr + (long)m * 64, lh);
      } else if (nw0 >= 2880 && nw0 < 3392) {
#pragma unroll
        for (int ni = 0; ni < 2; ++ni)
#pragma unroll
          for (int i = 0; i < 16; ++i) {
            const long uoff = (long)(nw0 - 2880 + ni * 32 + (i & 3) + 8 * (i >> 2)) * g.Lp * 2;
            const unsigned voff = (unsigned)(((b * 512 + 4 * lh) * g.Lp + t) * 2);
            *(u16*)((char*)g.vdt + uoff + voff) = bf1(acc[mi][ni][i]);
          }
      } else {
        u16* dst; int ld, base; bool sil = false;
        if (nw0 < 512) { dst = g.uf; ld = 512; base = 0; }
        else if (nw0 < 1280) { dst = g.cq; ld = 768; base = 512; }
        else if (nw0 < 1792) { dst = g.ckv; ld = 512; base = 1280; }
        else if (nw0 < 2368) { dst = g.qd; ld = 512; base = 1856; }
        else if (nw0 < 2880) { dst = g.kd; ld = 512; base = 2368; }
        else { dst = g.g; ld = 2048; base = 3392; sil = true; }
        if (nw0 >= 512 && nw0 < 1792) {
          float ss = 0.f;
#pragma unroll
          for (int ni = 0; ni < 2; ++ni)
#pragma unroll
            for (int i = 0; i < 16; ++i) ss += acc[mi][ni][i] * acc[mi][ni][i];
          atomicAdd(p.rowsq + (size_t)(l * 2 + (nw0 >= 1280 ? 1 : 0)) * 50432 + g.seq0 + m, ss);
        }
#pragma unroll
        for (int ni = 0; ni < 2; ++ni)
#pragma unroll
          for (int pr = 0; pr < 2; ++pr) {
            int n = nw0 - base + ni * 32 + 16 * pr;
            float v[8];
#pragma unroll
            for (int j = 0; j < 8; ++j) v[j] = acc[mi][ni][8 * pr + j];
            if (sil) {
#pragma unroll
              for (int j = 0; j < 8; ++j) v[j] = silu(v[j]);
            }
            store_bf8_pair(dst + (long)m * ld + n, lh, v[0], v[1], v[2], v[3], v[4], v[5], v[6], v[7]);
          }
      }
    }
  }
}

DI void phase_upproj(const Params& p, const GroupP& g, int l, char* smem, int vb) {
  const int tid = tid_(), lane = tid & 63, wid = __builtin_amdgcn_readfirstlane(tid >> 6);
  const int wm = wid >> 1, wn = wid & 1, lr = lane & 31, lh = lane >> 5;
  const int nmt = g.T / 256;
  u16* kn = g.xb;
  u16* vt = g.xb + (long)g.T * 1024;
  const int ntiles = nmt * 28;
  for (int it = vb; it < ((ntiles + 7) & ~7); it += gridDim.x) {
    const int tt = xcd_tile(it, ntiles);
    if (tt < 0) continue;
    int nt, mt;
    tile_mn(tt, nmt, 28, mt, nt);
    int m0 = mt * 256;
    f32x16 acc[4][2];
    float rs[4];
    if (nt < 28) {
      const bool isq = nt < 12;
      const int n0 = isq ? nt * 128 : (nt - 12) * 128;
      const u16* A = isq ? g.cq : g.ckv;
      const int Kd = isq ? 768 : 512;
      const u16* Bw = isq ? p.wuqT + (long)l * 1536 * 768 + (long)n0 * 768 : p.wukvT + (long)l * 2048 * 512 + (long)n0 * 512;
      gemm_main<true, false>([&](int kt) { return ASrc{A + kt * 64, (long)Kd}; }, m0, Bw, Kd, Kd, smem, acc, 0.f, rs);
      {
        const float* sq = p.rowsq + (size_t)(l * 2 + (isq ? 0 : 1)) * 50432 + g.seq0 + m0 + wm * 128 + lr;
        const float invK = 1.f / (float)Kd;
#pragma unroll
        for (int mi = 0; mi < 4; ++mi) rs[mi] = __builtin_amdgcn_rsqf(sq[mi * 32] * invK + 1e-6f);
      }
      const int nw0 = n0 + wn * 64;
      if (isq) {
        const int head = nw0 / 192, w = nw0 - head * 192;
#pragma unroll
        for (int mi = 0; mi < 4; ++mi) {
          int m = m0 + wm * 128 + mi * 32 + lr;
          float r = rs[mi];
          if (w == 128) {
            int b = m / g.Lp, t = m - b * g.Lp;
            f32x16 a0 = acc[mi][0], a1 = acc[mi][1];
#pragma unroll
            for (int i = 0; i < 16; ++i) { a0[i] *= r; a1[i] *= r; }
            rope_store(a0, a1, p.rope + t * 32, g.q + (long)m * 1536 + nw0, lh);
          } else {
            u16* qp = g.q + (long)m * 1536 + nw0;
#pragma unroll
            for (int ni = 0; ni < 2; ++ni)
#pragma unroll
              for (int pr = 0; pr < 2; ++pr)
                store_bf8_pair(qp + ni * 32 + 16 * pr, lh, acc[mi][ni][8 * pr] * r, acc[mi][ni][8 * pr + 1] * r,
                               acc[mi][ni][8 * pr + 2] * r, acc[mi][ni][8 * pr + 3] * r, acc[mi][ni][8 * pr + 4] * r,
                               acc[mi][ni][8 * pr + 5] * r, acc[mi][ni][8 * pr + 6] * r, acc[mi][ni][8 * pr + 7] * r);
          }
        }
      } else {
        const int head = n0 >> 8, isv = (n0 >> 7) & 1;
        if (!isv) {
#pragma unroll
          for (int mi = 0; mi < 4; ++mi) {
            int m = m0 + wm * 128 + mi * 32 + lr;
            float r = rs[mi];
            u16* kp = kn + (long)m * 1024 + head * 128 + wn * 64;
#pragma unroll
            for (int ni = 0; ni < 2; ++ni)
#pragma unroll
              for (int pr = 0; pr < 2; ++pr)
                store_bf8_pair(kp + ni * 32 + 16 * pr, lh, acc[mi][ni][8 * pr] * r, acc[mi][ni][8 * pr + 1] * r,
                               acc[mi][ni][8 * pr + 2] * r, acc[mi][ni][8 * pr + 3] * r, acc[mi][ni][8 * pr + 4] * r,
                               acc[mi][ni][8 * pr + 5] * r, acc[mi][ni][8 * pr + 6] * r, acc[mi][ni][8 * pr + 7] * r);
          }
        } else {
#pragma unroll
          for (int mi = 0; mi < 4; ++mi) {
            int m = m0 + wm * 128 + mi * 32 + lr;
            float r = rs[mi];
            int b = m / g.Lp, t = m - b * g.Lp;
            const unsigned voff = (unsigned)((((b * 8 + head) * 128 + 4 * lh) * g.Lp + t) * 2);
#pragma unroll
            for (int ni = 0; ni < 2; ++ni)
#pragma unroll
              for (int i = 0; i < 16; ++i) {
                const long uoff = (long)(wn * 64 + ni * 32 + (i & 3) + 8 * (i >> 2)) * g.Lp * 2;
                *(u16*)((char*)vt + uoff + voff) = bf1(acc[mi][ni][i] * r);
              }
          }
        }
      }
    }
  }
  {
    const int Hp = g.Hp, H = g.L >> 1, L = g.L, Lp = g.Lp;
    const int nft = (g.B * Hp) / 256;
    const int srow = tid >> 3, skc = tid & 7;
    char* sA = smem;
    char* sB = smem + 256 * 144;
    for (int it = vb; it < nft * 8; it += gridDim.x) {
      const int nt = it / nft, mt = it - nt * nft;
      const int m0 = mt * 256, n0 = nt * 128;
      const int gg = n0 >> 8, part = (n0 >> 7) & 1;
      const u16* Bw = p.mfT + (long)(l * 4 + gg) * 256 * 128 + (long)(n0 & 255) * 128;
      f32x16 acc[4][2];
#pragma unroll
      for (int mi = 0; mi < 4; ++mi)
#pragma unroll
        for (int ni = 0; ni < 2; ++ni)
#pragma unroll
          for (int i = 0; i < 16; ++i) acc[mi][ni][i] = 0.f;
      for (int kt = 0; kt < 2; ++kt) {
#pragma unroll
        for (int i = 0; i < 8; ++i) {
          const int row = srow + 32 * i;
          const int m = m0 + row;
          const int b = m / Hp, sidx = m - b * Hp;
          const bool pair = sidx >= 1 && sidx < H;
          const bool v1ok = (sidx <= H) && (pair || !part);
          u32x4 v1 = {0u, 0u, 0u, 0u}, v2 = {0u, 0u, 0u, 0u};
          if (v1ok) v1 = *(const u32x4*)(g.uf + ((long)(b * Lp + sidx)) * 512 + gg * 128 + kt * 64 + skc * 8);
          if (pair) v2 = *(const u32x4*)(g.uf + ((long)(b * Lp + L - sidx)) * 512 + gg * 128 + kt * 64 + skc * 8);
          u32x4 o;
#pragma unroll
          for (int j = 0; j < 4; ++j) {
            float a0 = bf_lo(v1[j]), a1 = bf_hi(v1[j]), b0 = bf_lo(v2[j]), b1 = bf_hi(v2[j]);
            o[j] = part ? pk2(a0 - b0, a1 - b1) : pk2(a0 + b0, a1 + b1);
          }
          *(u32x4*)(sA + row * 144 + skc * 16) = o;
        }
#pragma unroll
        for (int i = 0; i < 4; ++i)
          *(u32x4*)(sB + (srow + 32 * i) * 144 + skc * 16) = *(const u32x4*)(Bw + (long)(srow + 32 * i) * 128 + kt * 64 + skc * 8);
        __syncthreads();
#pragma unroll
        for (int ks = 0; ks < 4; ++ks) {
          bf16x8 af[4], bfr[2];
#pragma unroll
          for (int mi = 0; mi < 4; ++mi) af[mi] = *(const bf16x8*)(sA + (wm * 128 + mi * 32 + lr) * 144 + ks * 32 + lh * 16);
#pragma unroll
          for (int ni = 0; ni < 2; ++ni) bfr[ni] = *(const bf16x8*)(sB + (wn * 64 + ni * 32 + lr) * 144 + ks * 32 + lh * 16);
#pragma unroll
          for (int mi = 0; mi < 4; ++mi)
#pragma unroll
            for (int ni = 0; ni < 2; ++ni) acc[mi][ni] = MFMA(af[mi], bfr[ni], acc[mi][ni]);
        }
        __syncthreads();
      }
#pragma unroll
      for (int mi = 0; mi < 4; ++mi)
#pragma unroll
        for (int gi = 0; gi < 4; ++gi) {
          const int m = m0 + wm * 128 + mi * 32 + 8 * gi + 4 * lh;
          const int b = m / Hp, sidx = m - b * Hp;
#pragma unroll
          for (int ni = 0; ni < 2; ++ni) {
            const int d = wn * 64 + ni * 32 + lr;
            store_bf4(g.abt + ((long)(b * 512 + gg * 128 + d)) * (2 * Hp) + part * Hp + sidx, acc[mi][ni][4 * gi],
                      acc[mi][ni][4 * gi + 1], acc[mi][ni][4 * gi + 2], acc[mi][ni][4 * gi + 3]);
          }
        }
    }
  }
}

constexpr float SM_THR = 8.f;
DI void softmax_pv(f32x16 (&sa)[2], f32x16 (&O)[4], float& m, float& l, const char* sV, int lr, int lh, bool first) {
  float t0 = fmaxf(fmaxf(sa[0][0], sa[0][1]), sa[0][2]);
  float t1 = fmaxf(fmaxf(sa[1][0], sa[1][1]), sa[1][2]);
#pragma unroll
  for (int i = 3; i < 15; i += 2) {
    t0 = fmaxf(fmaxf(t0, sa[0][i]), sa[0][i + 1]);
    t1 = fmaxf(fmaxf(t1, sa[1][i]), sa[1][i + 1]);
  }
  float tmax = fmaxf(fmaxf(t0, t1), fmaxf(sa[0][15], sa[1][15]));
  tmax = fmaxf(tmax, __shfl_xor(tmax, 32, 64));
  if (first || __any(tmax > SM_THR)) {
    asm volatile("; rescale" ::: "memory");
    const float delta = first ? tmax : fmaxf(tmax, 0.f);
    const float alpha = __builtin_amdgcn_exp2f(-delta);
    m += delta;
    l *= alpha;
#pragma unroll
    for (int d = 0; d < 4; ++d)
#pragma unroll
      for (int i = 0; i < 16; ++i) O[d][i] *= alpha;
#pragma unroll
    for (int i = 0; i < 16; ++i) { sa[0][i] -= delta; sa[1][i] -= delta; }
  }
  float rsum0 = 0.f, rsum1 = 0.f;
#pragma unroll
  for (int i = 0; i < 16; ++i) {
    float p0 = __builtin_amdgcn_exp2f(sa[0][i]);
    float p1 = __builtin_amdgcn_exp2f(sa[1][i]);
    sa[0][i] = p0;
    sa[1][i] = p1;
    rsum0 += p0;
    rsum1 += p1;
  }
  l += rsum0 + rsum1;
  bf16x8 pf[4];
#pragma unroll
  for (int g4 = 0; g4 < 4; ++g4) {
    const int kb = g4 >> 1, s2 = g4 & 1;
    u32x4 pp;
#pragma unroll
    for (int j = 0; j < 4; ++j) pp[j] = pk2(sa[kb][8 * s2 + 2 * j], sa[kb][8 * s2 + 2 * j + 1]);
    pf[g4] = __builtin_bit_cast(bf16x8, pp);
  }
  const char* vrd = sV + lr * 144 + lh * 16;
  bf16x8 vfr[4];
#pragma unroll
  for (int t = 0; t < 3; ++t) vfr[t] = *(const bf16x8*)(vrd + (t & 3) * (32 * 144) + (t >> 2) * 32);
  __builtin_amdgcn_sched_group_barrier(0x100, 3, 0);
#pragma unroll
  for (int t = 0; t < 16; ++t) {
    if (t + 3 < 16) {
      vfr[(t + 3) & 3] = *(const bf16x8*)(vrd + ((t + 3) & 3) * (32 * 144) + ((t + 3) >> 2) * 32);
      __builtin_amdgcn_sched_group_barrier(0x100, 1, 0);
    }
    O[t & 3] = MFMA(vfr[t & 3], pf[t >> 2], O[t & 3]);
    __builtin_amdgcn_sched_group_barrier(0x008, 1, 0);
  }
}

DI void load_vtile(u32x4 (&rv)[4], const u16* __restrict__ vbase, int Lp, int key0, unsigned voffV) {
  const char* ub = (const char*)vbase + (long)key0 * 2;
#pragma unroll
  for (int i = 0; i < 4; ++i) rv[i] = *(const u32x4*)(ub + (long)(32 * i) * Lp * 2 + voffV);
}
DI void store_vtile(const u32x4 (&rv)[4], char* sVst) {
#pragma unroll
  for (int i = 0; i < 4; ++i) {
    u32x2 lo = {rv[i][0], rv[i][1]}, hi = {rv[i][2], rv[i][3]};
    *(u32x2*)(sVst + i * 4608) = lo;
    *(u32x2*)(sVst + i * 4608 + 16) = hi;
  }
}

DI void mla_item(const Params& p, const GroupP& g, int item, char* smem, bool dry) {
  const int tid = tid_(), lane = tid & 63, wid = __builtin_amdgcn_readfirstlane(tid >> 6), lr = lane & 31, lh = lane >> 5;
  const int nqb = g.Lp / 128;
  const int qb = item % nqb, bh = item / nqb, h = bh & 7, b = bh >> 3;
  const int Lp = g.Lp, L = g.L;
  char* sK = smem;
  char* sV = smem + 64 * 400;
  const u16* kn = g.xb + (long)b * Lp * 1024 + h * 128;
  const u16* kr = g.kr + (long)b * Lp * 64;
  const u16* vbase = g.xb + (long)g.T * 1024 + (long)(b * 8 + h) * 128 * Lp;
  const int qrow = b * Lp + qb * 128 + wid * 32 + lr;
  bf16x8 qf[12];
#pragma unroll
  for (int ks = 0; ks < 12; ++ks) qf[ks] = *(const bf16x8*)(g.q + (long)qrow * 1536 + h * 192 + ks * 16 + lh * 8);
  f32x16 O[4];
#pragma unroll
  for (int d = 0; d < 4; ++d)
#pragma unroll
    for (int i = 0; i < 16; ++i) O[d][i] = 0.f;
  float m = 0.f, l = 0.f;
  const int nkt = (L + 63) >> 6;
  u32x4 rk[6], rv[4];
  const unsigned voffKn = (unsigned)((tid >> 4) * 2048 + (tid & 15) * 16);
  const unsigned voffKr = (unsigned)((tid >> 3) * 128 + (tid & 7) * 16);
  const unsigned voffV = (unsigned)(((tid >> 3) * Lp + (tid & 7) * 8) * 2);
  char* sKn_st = sK + (tid >> 4) * 400 + (tid & 15) * 16;
  char* sKr_st = sK + (tid >> 3) * 400 + 256 + (tid & 7) * 16;
  char* sV_st = sV + (tid >> 3) * 144 + ((tid & 7) >> 1) * 32 + (tid & 1) * 8;
  auto loadK = [&](int kt) {
    const char* u1 = (const char*)kn + (long)kt * (64 * 2048);
#pragma unroll
    for (int i = 0; i < 4; ++i) rk[i] = *(const u32x4*)(u1 + i * (16 * 2048) + voffKn);
    const char* u2 = (const char*)kr + (long)kt * (64 * 128);
#pragma unroll
    for (int i = 0; i < 2; ++i) rk[4 + i] = *(const u32x4*)(u2 + i * (32 * 128) + voffKr);
  };
  auto storeK = [&]() {
#pragma unroll
    for (int i = 0; i < 4; ++i) *(u32x4*)(sKn_st + i * 6400) = rk[i];
#pragma unroll
    for (int i = 0; i < 2; ++i) *(u32x4*)(sKr_st + i * 12800) = rk[4 + i];
  };
  loadK(0);
  load_vtile(rv, vbase, Lp, 0, voffV);
  storeK();
  store_vtile(rv, sV_st);
  __syncthreads();
  for (int kt = 0; kt < nkt; ++kt) {
    const bool more = kt + 1 < nkt;
    if (more) loadK(kt + 1);
    __builtin_amdgcn_sched_barrier(0);
    f32x16 sa[2];
#pragma unroll
    for (int i = 0; i < 16; ++i) { sa[0][i] = -m; sa[1][i] = -m; }
    {
      const char* krd = sK + lr * 400 + lh * 16;
      bf16x8 kf[3][2];
#pragma unroll
      for (int q2 = 0; q2 < 2; ++q2) {
        kf[q2][0] = *(const bf16x8*)(krd + q2 * 32);
        kf[q2][1] = *(const bf16x8*)(krd + 32 * 400 + q2 * 32);
      }
      __builtin_amdgcn_sched_group_barrier(0x100, 4, 0);
#pragma unroll
      for (int ks = 0; ks < 12; ++ks) {
        if (ks + 2 < 12) {
          kf[(ks + 2) % 3][0] = *(const bf16x8*)(krd + (ks + 2) * 32);
          kf[(ks + 2) % 3][1] = *(const bf16x8*)(krd + 32 * 400 + (ks + 2) * 32);
          __builtin_amdgcn_sched_group_barrier(0x100, 2, 0);
        }
        sa[0] = MFMA(kf[ks % 3][0], qf[ks], sa[0]);
        sa[1] = MFMA(kf[ks % 3][1], qf[ks], sa[1]);
        __builtin_amdgcn_sched_group_barrier(0x008, 2, 0);
      }
    }
    if (kt == nkt - 1) {
      asm volatile("; masked tail tile" ::: "memory");
#pragma unroll
      for (int kb = 0; kb < 2; ++kb)
#pragma unroll
        for (int i = 0; i < 16; ++i)
          if (kt * 64 + kb * 32 + crow(i, lh) >= L) sa[kb][i] = -1e30f;
    }
    __syncthreads();
    if (more) { storeK(); load_vtile(rv, vbase, Lp, (kt + 1) * 64, voffV); }
    __builtin_amdgcn_sched_barrier(0);
    softmax_pv(sa, O, m, l, sV, lr, lh, kt == 0);
    __syncthreads();
    if (more) store_vtile(rv, sV_st);
  }
  float lt = l + __shfl_xor(l, 32, 64);
  float inv = 1.f / lt;
  const u16* gp = g.g + (long)qrow * 2048 + 512 + h * 128;
  u16* op = (dry ? (u16*)g.out : g.q) + (long)qrow * 1536 + h * 192;
#pragma unroll
  for (int d = 0; d < 4; ++d)
#pragma unroll
    for (int pr = 0; pr < 2; ++pr) {
      const int dd = d * 32 + 16 * pr;
      u32x2 ga, gb;
      load_bf8_pair(gp + dd, lh, ga, gb);
      store_bf8_pair(op + dd, lh, O[d][8 * pr] * inv * bf_lo(ga[0]), O[d][8 * pr + 1] * inv * bf_hi(ga[0]),
                     O[d][8 * pr + 2] * inv * bf_lo(ga[1]), O[d][8 * pr + 3] * inv * bf_hi(ga[1]),
                     O[d][8 * pr + 4] * inv * bf_lo(gb[0]), O[d][8 * pr + 5] * inv * bf_hi(gb[0]),
                     O[d][8 * pr + 6] * inv * bf_lo(gb[1]), O[d][8 * pr + 7] * inv * bf_hi(gb[1]));
    }
  __syncthreads();
}

DI int t5_bucket(int rel) {
  int n = rel < 0 ? -rel : rel;
  int bk;
  if (n < 8) bk = n;
  else if (n < 12) bk = 8;
  else if (n < 16) bk = 9;
  else if (n < 23) bk = 10;
  else if (n < 32) bk = 11;
  else if (n < 46) bk = 12;
  else if (n < 64) bk = 13;
  else if (n < 91) bk = 14;
  else bk = 15;
  return bk + (rel > 0 ? 16 : 0);
}

DI void diff_item(const Params& p, const GroupP& g, int l_layer, int item, char* smem, bool dry) {
  const int tid = tid_(), lane = tid & 63, wid = __builtin_amdgcn_readfirstlane(tid >> 6), lr = lane & 31, lh = lane >> 5;
  const int nqb = (g.L + 63) / 64;
  const int qb = item % nqb, bh = item / nqb, h = bh & 3, b = bh >> 2;
  const int Lp = g.Lp, L = g.L;
  const int map = wid >> 1, qs = wid & 1;
  char* sK = smem;
  char* sV = smem + 64 * 272;
  float* sBias = (float*)(smem + 64 * 272 + 128 * 144);
  float* o2buf = (float*)smem;
  const u16* kd = g.kd + (long)b * Lp * 512 + h * 128;
  const u16* vbase = g.vdt + (long)(b * 4 + h) * 128 * Lp;
  const int qpos = qb * 64 + qs * 32 + lr;
  const long qrow = (long)b * Lp + qpos;
  for (int i = tid; i < 257; i += NTHR) sBias[i] = p.rel_bias[t5_bucket(i - 128) * 4 + h] * LOG2E;
  const float bneg = p.rel_bias[15 * 4 + h] * LOG2E, bpos = p.rel_bias[31 * 4 + h] * LOG2E;
  bf16x8 qf[4];
#pragma unroll
  for (int ks = 0; ks < 4; ++ks) qf[ks] = *(const bf16x8*)(g.qd + qrow * 512 + h * 128 + map * 64 + ks * 16 + lh * 8);
  f32x16 O[4];
#pragma unroll
  for (int d = 0; d < 4; ++d)
#pragma unroll
    for (int i = 0; i < 16; ++i) O[d][i] = 0.f;
  float m = 0.f, l = 0.f;
  const int nkt = (L + 63) >> 6;
  u32x4 rk[4], rv[4];
  const unsigned voffK = (unsigned)((tid >> 4) * 1024 + (tid & 15) * 16);
  const unsigned voffV = (unsigned)(((tid >> 3) * Lp + (tid & 7) * 8) * 2);
  char* sK_st = sK + (tid >> 4) * 272 + (tid & 15) * 16;
  char* sV_st = sV + (tid >> 3) * 144 + ((tid & 7) >> 1) * 32 + (tid & 1) * 8;
  auto loadK = [&](int kt) {
    const char* u1 = (const char*)kd + (long)kt * (64 * 1024);
#pragma unroll
    for (int i = 0; i < 4; ++i) rk[i] = *(const u32x4*)(u1 + i * (16 * 1024) + voffK);
  };
  auto storeK = [&]() {
#pragma unroll
    for (int i = 0; i < 4; ++i) *(u32x4*)(sK_st + i * (16 * 272)) = rk[i];
  };
  const int qw0 = qb * 64 + qs * 32;
  loadK(0);
  load_vtile(rv, vbase, Lp, 0, voffV);
  storeK();
  store_vtile(rv, sV_st);
  __syncthreads();
  for (int kt = 0; kt < nkt; ++kt) {
    const bool more = kt + 1 < nkt;
    if (more) loadK(kt + 1);
    __builtin_amdgcn_sched_barrier(0);
    const int key0 = kt * 64;
    const int relmin = key0 - (qw0 + 31), relmax = key0 + 63 - qw0;
    const bool farp = relmin >= 128, farn = relmax <= -128;
    const float binit = (farp ? bpos : (farn ? bneg : 0.f)) - m;
    f32x16 sa[2];
#pragma unroll
    for (int i = 0; i < 16; ++i) { sa[0][i] = binit; sa[1][i] = binit; }
    {
      const char* krd = sK + lr * 272 + map * 128 + lh * 16;
      bf16x8 kf[4][2];
#pragma unroll
      for (int ks = 0; ks < 4; ++ks) {
        kf[ks][0] = *(const bf16x8*)(krd + ks * 32);
        kf[ks][1] = *(const bf16x8*)(krd + 32 * 272 + ks * 32);
      }
#pragma unroll
      for (int ks = 0; ks < 4; ++ks) {
        sa[0] = MFMA(kf[ks][0], qf[ks], sa[0]);
        sa[1] = MFMA(kf[ks][1], qf[ks], sa[1]);
      }
    }
    if (!farp && !farn) {
      asm volatile("; near-diagonal bias tile" ::: "memory");
#pragma unroll
      for (int kb = 0; kb < 2; ++kb)
#pragma unroll
        for (int i = 0; i < 16; ++i) {
          int rel = key0 + kb * 32 + crow(i, lh) - qpos;
          rel = rel < -128 ? -128 : (rel > 128 ? 128 : rel);
          sa[kb][i] += sBias[rel + 128];
        }
    }
    if (kt == nkt - 1) {
      asm volatile("; masked tail tile" ::: "memory");
#pragma unroll
      for (int kb = 0; kb < 2; ++kb)
#pragma unroll
        for (int i = 0; i < 16; ++i)
          if (key0 + kb * 32 + crow(i, lh) >= L) sa[kb][i] = -1e30f;
    }
    __syncthreads();
    if (more) { storeK(); load_vtile(rv, vbase, Lp, (kt + 1) * 64, voffV); }
    __builtin_amdgcn_sched_barrier(0);
    softmax_pv(sa, O, m, l, sV, lr, lh, kt == 0);
    __syncthreads();
    if (more) store_vtile(rv, sV_st);
  }
  float lt = l + __shfl_xor(l, 32, 64);
  float inv = 1.f / lt;
  if (map == 1) {
#pragma unroll
    for (int d = 0; d < 4; ++d)
#pragma unroll
      for (int i = 0; i < 16; ++i) o2buf[(d * 32 + crow(i, lh)) * 64 + qs * 32 + lr] = O[d][i] * inv;
  }
  __syncthreads();
  if (map == 0) {
    const float lam = p.lam[l_layer];
    const float lam_init = l_layer ? 0.35550906759f : 0.2f;
    float ss = 0.f;
#pragma unroll
    for (int d = 0; d < 4; ++d)
#pragma unroll
      for (int i = 0; i < 16; ++i) {
        float o = O[d][i] * inv - lam * o2buf[(d * 32 + crow(i, lh)) * 64 + qs * 32 + lr];
        O[d][i] = o;
        ss += o * o;
      }
    ss += __shfl_xor(ss, 32, 64);
    float r = __builtin_amdgcn_rsqf(ss * (1.f / 128.f) + 1e-5f) * (1.f - lam_init);
    const u16* gp = g.g + qrow * 2048 + 1536 + h * 128;
    const float* dn = p.diff_norm + l_layer * 128;
    u16* op = (dry ? (u16*)g.out + (long)g.T * 1536 : g.qd) + qrow * 512 + h * 128;
#pragma unroll
    for (int d = 0; d < 4; ++d)
#pragma unroll
      for (int pr = 0; pr < 2; ++pr) {
        const int dd = d * 32 + 16 * pr;
        u32x2 ga, gb;
        load_bf8_pair(gp + dd, lh, ga, gb);
        const float4 wa = *(const float4*)(dn + dd + 4 * lh);
        const float4 wb = *(const float4*)(dn + dd + 8 + 4 * lh);
        store_bf8_pair(op + dd, lh, O[d][8 * pr] * r * wa.x * bf_lo(ga[0]), O[d][8 * pr + 1] * r * wa.y * bf_hi(ga[0]),
                       O[d][8 * pr + 2] * r * wa.z * bf_lo(ga[1]), O[d][8 * pr + 3] * r * wa.w * bf_hi(ga[1]),
                       O[d][8 * pr + 4] * r * wb.x * bf_lo(gb[0]), O[d][8 * pr + 5] * r * wb.y * bf_hi(gb[0]),
                       O[d][8 * pr + 6] * r * wb.z * bf_lo(gb[1]), O[d][8 * pr + 7] * r * wb.w * bf_hi(gb[1]));
      }
  }
  __syncthreads();
}

DI float* dft_part(const GroupP& g, int part) { return (float*)g.cq + (size_t)part * g.B * g.Hp * 512; }
DI void dft_item(const Params& p, const GroupP& g, int item, char* smem) {
  const int tid = tid_(), lane = tid & 63, wid = __builtin_amdgcn_readfirstlane(tid >> 6);
  const int wm = wid >> 1, wn = wid & 1, lr = lane & 31, lh = lane >> 5;
  const int nb8 = g.B * 8;
  int mt = item / nb8, r = item - mt * nb8;
  int b = r >> 3, nt = (r >> 1) & 3, part = r & 1;
  int m0 = mt * 256, n0 = nt * 128;
  const int Hp = g.Hp, K2 = 2 * Hp;
  f32x16 acc[4][2];
  const u16* A = g.fm + part * Hp;
  float rsd[4];
  gemm_main<true, false>([&](int kt) { return ASrc{A + kt * 64, (long)K2}; }, m0, g.abt + ((long)b * 512 + n0) * K2 + part * Hp, K2, Hp, smem, acc, 0.f, rsd);
  float* dst = dft_part(g, part) + (size_t)b * Hp * 512;
#pragma unroll
  for (int mi = 0; mi < 4; ++mi) {
    int mm = m0 + wm * 128 + mi * 32 + lr;
    if (mm >= Hp) continue;
#pragma unroll
    for (int ni = 0; ni < 2; ++ni)
#pragma unroll
      for (int gi = 0; gi < 4; ++gi) {
        int n = n0 + wn * 64 + ni * 32 + 8 * gi + 4 * lh;
        float4 o = {acc[mi][ni][4 * gi], acc[mi][ni][4 * gi + 1], acc[mi][ni][4 * gi + 2], acc[mi][ni][4 * gi + 3]};
        *(float4*)(dst + (size_t)mm * 512 + n) = o;
      }
  }
}

DI void phase_dftfin(const GroupP& g, int vb) {
  const int tid = tid_();
  const int H = g.L >> 1, Hp = g.Hp, L = g.L, Lp = g.Lp;
  const float* P = dft_part(g, 0);
  const float* Q = dft_part(g, 1);
  const int total = g.B * (H + 1) * 128;
  for (int i = vb * NTHR + tid; i < total; i += gridDim.x * NTHR) {
    const int c = i & 127, rk = i >> 7;
    const int b = rk / (H + 1), k = rk - b * (H + 1);
    const size_t src = ((size_t)b * Hp + k) * 512 + c * 4;
    const float4 pv = *(const float4*)(P + src);
    const float4 qv = *(const float4*)(Q + src);
    const long row1 = (long)b * Lp + k;
    const u32x2 g1 = *(const u32x2*)(g.g + row1 * 2048 + c * 4);
    store_bf4(g.uf + row1 * 512 + c * 4, (pv.x + qv.x) * bf_lo(g1[0]), (pv.y + qv.y) * bf_hi(g1[0]), (pv.z + qv.z) * bf_lo(g1[1]),
              (pv.w + qv.w) * bf_hi(g1[1]));
    if (k >= 1 && k < H) {
      const long row2 = (long)b * Lp + (L - k);
      const u32x2 g2 = *(const u32x2*)(g.g + row2 * 2048 + c * 4);
      store_bf4(g.uf + row2 * 512 + c * 4, (pv.x - qv.x) * bf_lo(g2[0]), (pv.y - qv.y) * bf_hi(g2[0]), (pv.z - qv.z) * bf_lo(g2[1]),
                (pv.w - qv.w) * bf_hi(g2[1]));
    }
  }
}

DI int pad8(int n) { return (n + 7) & ~7; }

DI void phase_mix(const Params& p, int l, char* smem, int xcc) {
  const GroupP& ga = p.grp[0];
  const GroupP& gb = p.grp[1];
  int* s_item = (int*)(smem + SMEM_BYTES - 16);
  const int G = gridDim.x;
  {
    const int nDft1 = gb.B * ((gb.Hp + 255) / 256) * 8;
    const int nDft0 = ga.B * ((ga.Hp + 255) / 256) * 8;
    for (int it = blockIdx.x; it < pad8(nDft1); it += G) {
      const int tt = xcd_tile(it, nDft1);
      if (tt >= 0) dft_item(p, gb, tt, smem);
    }
    const int vb = (blockIdx.x + G - pad8(nDft1) % G) % G;
    for (int it = vb; it < pad8(nDft0); it += G) {
      const int tt = xcd_tile(it, nDft0);
      if (tt >= 0) dft_item(p, ga, tt, smem);
    }
  }
  const int nqbMa = ga.Lp / 128, nqbDa = (ga.L + 63) / 64, nqbMb = gb.Lp / 128, nqbDb = (gb.L + 63) / 64;
  const int nMa = ga.B * nqbMa, nDa = (ga.B >> 1) * nqbDa;
  const int nMb = gb.B * nqbMb, nDb = (gb.B >> 1) * nqbDb;
  const int e0 = nMa, e1 = e0 + nDa, e2 = e1 + nMb, perX = e2 + nDb;
  int* ctrb = p.ctr + l * 8;
  for (int steal = 0; steal < 8; ++steal) {
    const int q = (xcc + steal) & 7;
    for (;;) {
      if (threadIdx.x == 0) *s_item = atomicAdd(&ctrb[q], 1);
      __syncthreads();
      const int j = *s_item;
      __syncthreads();
      if (j >= perX) break;
      if (j < e0) {
        const int pl = j / nqbMa, qb = j - pl * nqbMa;
        mla_item(p, ga, (q + 8 * pl) * nqbMa + qb, smem, false);
      } else if (j < e1) {
        const int jj = j - e0;
        const int pl = jj / nqbDa, qb = jj - pl * nqbDa;
        diff_item(p, ga, l, (q + 8 * pl) * nqbDa + qb, smem, false);
      } else if (j < e2) {
        const int jj = j - e1;
        const int pl = jj / nqbMb, qb = jj - pl * nqbMb;
        mla_item(p, gb, (q + 8 * pl) * nqbMb + qb, smem, false);
      } else {
        const int jj = j - e2;
        const int pl = jj / nqbDb, qb = jj - pl * nqbDb;
        diff_item(p, gb, l, (q + 8 * pl) * nqbDb + qb, smem, false);
      }
    }
  }
}

DI void phase_outproj(const Params& p, const GroupP& g, int l, char* smem, int vb) {
  const int tid = tid_(), lane = tid & 63, wid = __builtin_amdgcn_readfirstlane(tid >> 6);
  const int wm = wid >> 1, wn = wid & 1, lr = lane & 31, lh = lane >> 5;
  const int nmt = g.T / 256;
  const u16* W = p.woT + (long)l * DM * DM;
  const int ntiles = nmt * 16;
  for (int it = vb; it < ((ntiles + 7) & ~7); it += gridDim.x) {
    const int tt = xcd_tile(it, ntiles);
    if (tt < 0) continue;
    int nt, mt;
    tile_mn(tt, nmt, 16, mt, nt);
    int m0 = mt * 256, n0 = nt * 128;
    f32x16 acc[4][2];
    const u16 *uf = g.uf, *q = g.q, *qd = g.qd;
    float rsd[4];
    gemm_main<true, false>(
        [&](int kt) {
          int k0 = kt * 64;
          if (k0 < 512) return ASrc{uf + k0, 512};
          if (k0 < 1536) { int kk = k0 - 512; return ASrc{q + (kk >> 7) * 192 + (kk & 127), 1536}; }
          return ASrc{qd + (k0 - 1536), 512};
        },
        m0, W + (long)n0 * DM, DM, DM, smem, acc, 0.f, rsd);
#pragma unroll
    for (int mi = 0; mi < 4; ++mi) {
      int m = m0 + wm * 128 + mi * 32 + lr;
      int b = m / g.Lp, t = m - b * g.Lp;
      if (t >= g.L) continue;
      if (l == 0) {
        const float* res = (t < 16) ? p.meta + t * DM : g.x + ((long)b * (g.L - 16) + (t - 16)) * DM;
        u16* dst = g.h1b + (long)m * DM;
        float ss = 0.f;
#pragma unroll
        for (int ni = 0; ni < 2; ++ni)
#pragma unroll
          for (int pr = 0; pr < 2; ++pr) {
            const int n = n0 + wn * 64 + ni * 32 + 16 * pr;
            const float4 ra = *(const float4*)(res + n + 4 * lh);
            const float4 rb = *(const float4*)(res + n + 8 + 4 * lh);
            const float a0 = ra.x + acc[mi][ni][8 * pr], a1 = ra.y + acc[mi][ni][8 * pr + 1];
            const float a2 = ra.z + acc[mi][ni][8 * pr + 2], a3 = ra.w + acc[mi][ni][8 * pr + 3];
            const float b0 = rb.x + acc[mi][ni][8 * pr + 4], b1 = rb.y + acc[mi][ni][8 * pr + 5];
            const float b2 = rb.z + acc[mi][ni][8 * pr + 6], b3 = rb.w + acc[mi][ni][8 * pr + 7];
            store_bf8_pair(dst + n, lh, a0, a1, a2, a3, b0, b1, b2, b3);
            ss += a0 * a0 + a1 * a1 + a2 * a2 + a3 * a3 + b0 * b0 + b1 * b1 + b2 * b2 + b3 * b3;
          }
        atomicAdd(p.rowsq + (size_t)4 * 50432 + g.seq0 + m, ss);
      } else {
        if (t < 16) continue;
        const u16* res = g.h1b + (long)m * DM;
        float* dst = g.out + ((long)b * (g.L - 16) + (t - 16)) * DM;
#pragma unroll
        for (int ni = 0; ni < 2; ++ni)
#pragma unroll
          for (int pr = 0; pr < 2; ++pr) {
            const int n = n0 + wn * 64 + ni * 32 + 16 * pr;
            u32x2 ra, rb;
            load_bf8_pair(res + n, lh, ra, rb);
            float4 oa = {bf_lo(ra[0]) + acc[mi][ni][8 * pr], bf_hi(ra[0]) + acc[mi][ni][8 * pr + 1],
                         bf_lo(ra[1]) + acc[mi][ni][8 * pr + 2], bf_hi(ra[1]) + acc[mi][ni][8 * pr + 3]};
            float4 ob = {bf_lo(rb[0]) + acc[mi][ni][8 * pr + 4], bf_hi(rb[0]) + acc[mi][ni][8 * pr + 5],
                         bf_lo(rb[1]) + acc[mi][ni][8 * pr + 6], bf_hi(rb[1]) + acc[mi][ni][8 * pr + 7]};
            *(float4*)(dst + n + 4 * lh) = oa;
            *(float4*)(dst + n + 8 + 4 * lh) = ob;
          }
      }
    }
  }
}

DI void phase_final(const Params& p) {
  const int tid = tid_(), lane = tid & 63, wid = __builtin_amdgcn_readfirstlane(tid >> 6);
  const int rows0 = p.grp[0].B * (p.grp[0].L - 16), rows1 = p.grp[1].B * (p.grp[1].L - 16);
  for (int it = blockIdx.x; it < (rows0 + rows1) / 4; it += gridDim.x) {
    int row = it * 4 + wid;
    float* ptr = (row < rows0) ? p.grp[0].out + (long)row * DM : p.grp[1].out + (long)(row - rows0) * DM;
    float4 v[8];
    float ss = 0.f;
#pragma unroll
    for (int i = 0; i < 8; ++i) {
      v[i] = *(const float4*)(ptr + (i * 64 + lane) * 4);
      ss += v[i].x * v[i].x + v[i].y * v[i].y + v[i].z * v[i].z + v[i].w * v[i].w;
    }
    ss = wave_sum(ss);
    float r = __builtin_amdgcn_rsqf(ss * (1.f / DM) + 1e-6f);
#pragma unroll
    for (int i = 0; i < 8; ++i) {
      float4 w = *(const float4*)(p.final_norm + (i * 64 + lane) * 4);
      float4 o = {v[i].x * r * w.x, v[i].y * r * w.y, v[i].z * r * w.z, v[i].w * r * w.w};
      *(float4*)(ptr + (i * 64 + lane) * 4) = o;
    }
  }
}

#define XB_TMO      128
#define XB_XCNT(j)  (256  + 64 * (j))
#define XB_XSUB(j)  (1280 + 64 * (j))
#define XB_XGEN(j)  (2304 + 64 * (j))
#define XB_TOP      3328
#define XB_TOPGEN   3392
#define XCD_BAR_WORDS 3456
#define XB_SPIN_CAP (1u << 22)
#define LAS __attribute__((address_space(3)))
DI unsigned xb_ld(unsigned* p) { return __hip_atomic_load(p, __ATOMIC_RELAXED, __HIP_MEMORY_SCOPE_AGENT); }
DI unsigned xb_add(unsigned* p, unsigned v) { return __hip_atomic_fetch_add(p, v, __ATOMIC_RELAXED, __HIP_MEMORY_SCOPE_AGENT); }
DI unsigned xb_xcc_id() { return (unsigned)__builtin_amdgcn_s_getreg((3 << 11) | 20) & 0xFu; }
#define XB_SPIN(cond, bar) do { unsigned _sp = 0; while (cond) { __builtin_amdgcn_s_sleep(1); \
    if ((++_sp & 255u) == 0u) { if (xb_ld(&(bar)[XB_TMO])) break; if (_sp > XB_SPIN_CAP) { atomicAdd(&(bar)[XB_TMO], 1u); break; } } } } while (0)
struct XcdBarrier { unsigned* bar; unsigned x; volatile LAS unsigned* st; };
DI XcdBarrier xcd_barrier_post(unsigned* bar, volatile LAS unsigned* st) {
  XcdBarrier b; b.bar = bar; b.x = xb_xcc_id(); b.st = st;
  if (threadIdx.x == 0) (void)xb_add(&bar[XB_XCNT(b.x)], 1u);
  return b;
}
DI void xcd_barrier_complete(unsigned* bar, unsigned x, unsigned& nloc, unsigned& nx) {
  const unsigned G = gridDim.x * gridDim.y * gridDim.z;
  unsigned sum, cnt, mine, sp = 0u;
  for (;;) {
    sum = 0u; cnt = 0u; mine = 0u;
#pragma unroll
    for (unsigned j = 0; j < 16; ++j) { const unsigned c = xb_ld(&bar[XB_XCNT(j)]); sum += c; cnt += (c > 0u) ? 1u : 0u; mine = (j == x) ? c : mine; }
    if (sum == G) break;
    __builtin_amdgcn_s_sleep(1);
    if ((++sp & 255u) == 0u) { if (xb_ld(&bar[XB_TMO])) break; if (sp > XB_SPIN_CAP) { atomicAdd(&bar[XB_TMO], 1u); break; } }
  }
  nloc = mine > 0u ? mine : 1u; nx = cnt > 0u ? cnt : 1u;
}
DI void xcd_barrier(const XcdBarrier& b) {
  asm volatile("s_waitcnt vmcnt(0)" ::: "memory");
  __syncthreads();
  if (threadIdx.x == 0) {
    unsigned* bar = b.bar;
    __builtin_amdgcn_s_waitcnt(0);
    unsigned nloc = b.st[0], nx = b.st[1];
    if (nloc == 0u) { xcd_barrier_complete(bar, b.x, nloc, nx); b.st[0] = nloc; b.st[1] = nx; }
    const unsigned old = xb_add(&bar[XB_XSUB(b.x)], 1u);
    const unsigned gen = old / nloc;
    if (old + 1u == (gen + 1u) * nloc) {
      __builtin_amdgcn_fence(__ATOMIC_RELEASE, "agent");
      asm volatile("s_waitcnt vmcnt(0)" ::: "memory");
      const unsigned og = xb_add(&bar[XB_TOP], 1u);
      const unsigned tg = og / nx;
      if (og + 1u == (tg + 1u) * nx) xb_add(&bar[XB_TOPGEN], 1u);
      else XB_SPIN(xb_ld(&bar[XB_TOPGEN]) == tg, bar);
      __builtin_amdgcn_fence(__ATOMIC_ACQUIRE, "agent");
      xb_add(&bar[XB_XGEN(b.x)], 1u);
      asm volatile("s_waitcnt vmcnt(0)" ::: "memory");
    } else {
      XB_SPIN(xb_ld(&bar[XB_XGEN(b.x)]) == gen, bar);
      __builtin_amdgcn_fence(__ATOMIC_ACQUIRE, "agent");
      asm volatile("s_waitcnt vmcnt(0)" ::: "memory");
    }
  }
  __syncthreads();
}

constexpr int NPHASE = 12;

__global__ void __launch_bounds__(NTHR, 2) mega(Params p_unused, int ph_lo, int ph_hi) {
  __shared__ __attribute__((aligned(16))) char smem[SMEM_BYTES];
  __shared__ uint4 xb_words;
  if (threadIdx.x == 0) xb_words = make_uint4(0u, 0u, 0u, 0u);
  __syncthreads();
  {
    typedef const __attribute__((address_space(4))) Params* CPP0;
    CPP0 kp0 = (CPP0)__builtin_amdgcn_kernarg_segment_ptr();
    (void)xcd_barrier_post(kp0->bar, (volatile LAS unsigned*)&xb_words);
  }
  for (int ph = ph_lo; ph < ph_hi; ++ph) {
    typedef const __attribute__((address_space(4))) char* CP;
    CP kq = (CP)__builtin_amdgcn_kernarg_segment_ptr();
    asm volatile("" : "+s"(kq));
    typedef const __attribute__((address_space(4))) Params* CPP;
    CPP kp = (CPP)kq;
    Params p;
    p.grp[0].x = kp->grp[0].x;
    p.grp[0].out = kp->grp[0].out;
    p.grp[0].B = kp->grp[0].B;
    p.grp[0].L = kp->grp[0].L;
    p.grp[0].Lp = kp->grp[0].Lp;
    p.grp[0].T = kp->grp[0].T;
    p.grp[0].seq0 = kp->grp[0].seq0;
    p.grp[0].Hp = kp->grp[0].Hp;
    p.grp[0].xb = kp->grp[0].xb;
    p.grp[0].uf = kp->grp[0].uf;
    p.grp[0].cq = kp->grp[0].cq;
    p.grp[0].ckv = kp->grp[0].ckv;
    p.grp[0].kr = kp->grp[0].kr;
    p.grp[0].qd = kp->grp[0].qd;
    p.grp[0].kd = kp->grp[0].kd;
    p.grp[0].vdt = kp->grp[0].vdt;
    p.grp[0].g = kp->grp[0].g;
    p.grp[0].q = kp->grp[0].q;
    p.grp[0].abt = kp->grp[0].abt;
    p.grp[0].fm = kp->grp[0].fm;
    p.grp[0].h1b = kp->grp[0].h1b;
    p.grp[1].x = kp->grp[1].x;
    p.grp[1].out = kp->grp[1].out;
    p.grp[1].B = kp->grp[1].B;
    p.grp[1].L = kp->grp[1].L;
    p.grp[1].Lp = kp->grp[1].Lp;
    p.grp[1].T = kp->grp[1].T;
    p.grp[1].seq0 = kp->grp[1].seq0;
    p.grp[1].Hp = kp->grp[1].Hp;
    p.grp[1].xb = kp->grp[1].xb;
    p.grp[1].uf = kp->grp[1].uf;
    p.grp[1].cq = kp->grp[1].cq;
    p.grp[1].ckv = kp->grp[1].ckv;
    p.grp[1].kr = kp->grp[1].kr;
    p.grp[1].qd = kp->grp[1].qd;
    p.grp[1].kd = kp->grp[1].kd;
    p.grp[1].vdt = kp->grp[1].vdt;
    p.grp[1].g = kp->grp[1].g;
    p.grp[1].q = kp->grp[1].q;
    p.grp[1].abt = kp->grp[1].abt;
    p.grp[1].fm = kp->grp[1].fm;
    p.grp[1].h1b = kp->grp[1].h1b;
    p.meta = kp->meta;
    p.rel_bias = kp->rel_bias;
    p.final_norm = kp->final_norm;
    p.norm_w = kp->norm_w;
    p.w_in = kp->w_in;
    p.w_fmix = kp->w_fmix;
    p.q_norm = kp->q_norm;
    p.w_uq = kp->w_uq;
    p.kv_norm = kp->kv_norm;
    p.w_ukv = kp->w_ukv;
    p.lq1 = kp->lq1;
    p.lk1 = kp->lk1;
    p.lq2 = kp->lq2;
    p.lk2 = kp->lk2;
    p.diff_norm = kp->diff_norm;
    p.w_o = kp->w_o;
    p.winT = kp->winT;
    p.wuqT = kp->wuqT;
    p.wukvT = kp->wukvT;
    p.woT = kp->woT;
    p.mfT = kp->mfT;
    p.rope = kp->rope;
    p.lam = kp->lam;
    p.hmeta = kp->hmeta;
    p.ctr = kp->ctr;
    p.bar = kp->bar;
    p.rowsq = kp->rowsq;
    if (ph == 11) {
      phase_final(p);
    } else {
      const int l = ph >= 6 ? 1 : 0, st = ph >= 6 ? ph - 5 : ph;
      const GroupP& g0 = p.grp[0];
      const GroupP& g1 = p.grp[1];
      const int G = gridDim.x, bid = blockIdx.x;
      if (st == 0) {
        if (ph == 0) phase_wprep(p, &kp->rope_hi[0], &kp->rope_lo[0], smem, 0);
        phase_rowprep(p, g1, l, bid);
        phase_rowprep(p, g0, l, (bid + G - (g1.T / 4) % G) % G);
      } else if (st == 1) {
        phase_inproj(p, g1, l, smem, bid);
        phase_inproj(p, g0, l, smem, (bid + G - pad8((g1.T / 256) * 43) % G) % G);
        if (l == 0) {
          phase_wprep(p, &kp->rope_hi[0], &kp->rope_lo[0], smem, 1);
          phase_dftfill(g1, G - 1 - bid);
          phase_dftfill(g0, G - 1 - bid);
        }
      } else if (st == 2) {
        phase_upproj(p, g1, l, smem, bid);
        phase_upproj(p, g0, l, smem, (bid + G - pad8((g1.T / 256) * 28) % G) % G);
      } else if (st == 3) {
        phase_mix(p, l, smem, (int)(xb_xcc_id() & 7u));
      } else if (st == 4) {
        phase_dftfin(g1, bid);
        phase_dftfin(g0, bid);
      } else {
        phase_outproj(p, g1, l, smem, bid);
        phase_outproj(p, g0, l, smem, (bid + G - pad8((g1.T / 256) * 16) % G) % G);
      }
    }
    if (ph + 1 < ph_hi) {
      XcdBarrier xb;
      xb.bar = p.bar; xb.x = xb_xcc_id(); xb.st = (volatile LAS unsigned*)&xb_words;
      xcd_barrier(xb);
    }
    if (ph_hi == 0x7fffffff) cg::this_grid().sync();
  }
}

extern "C" void kernel_launch(void* const* d_in, const int* in_sizes, int n_in, void* d_out, int out_size, void* d_ws,
                              size_t ws_size, hipStream_t stream) {
  Params p;
  memset(&p, 0, sizeof(p));
  const float* x_prompt = (const float*)d_in[0];
  const float* x_sample = (const float*)d_in[1];
  p.meta = (const float*)d_in[2];
  p.rel_bias = (const float*)d_in[3];
  p.final_norm = (const float*)d_in[4];
  p.norm_w = (const float*)d_in[5];
  p.w_in = (const float*)d_in[6];
  p.w_fmix = (const float*)d_in[7];
  p.q_norm = (const float*)d_in[8];
  p.w_uq = (const float*)d_in[9];
  p.kv_norm = (const float*)d_in[10];
  p.w_ukv = (const float*)d_in[11];
  p.lq1 = (const float*)d_in[12];
  p.lk1 = (const float*)d_in[13];
  p.lq2 = (const float*)d_in[14];
  p.lk2 = (const float*)d_in[15];
  p.diff_norm = (const float*)d_in[16];
  p.w_o = (const float*)d_in[17];

  for (int c = 0; c < 32; ++c) {
    double inv = pow(10000.0, -(double)c / 32.0) / (2.0 * 3.14159265358979323846);
    float hi = (float)inv;
    p.rope_hi[c] = hi;
    p.rope_lo[c] = (float)(inv - (double)hi);
  }
  char* ws = (char*)d_ws;
  size_t off = 0;
  auto take = [&](size_t bytes) { char* r = ws + off; off += (bytes + 255) & ~(size_t)255; return r; };
  p.winT = (u16*)take((size_t)2 * INWP * DM * 2);
  p.wuqT = (u16*)take((size_t)2 * 1536 * 768 * 2);
  p.wukvT = (u16*)take((size_t)2 * 2048 * 512 * 2);
  p.woT = (u16*)take((size_t)2 * DM * DM * 2);
  p.mfT = (u16*)take((size_t)2 * 4 * 256 * 128 * 2);
  p.rope = (float2*)take((size_t)8320 * 32 * 8);
  p.lam = (float*)take(256);
  p.hmeta = (float*)take((size_t)10 * 16 * DM * 4);
  p.ctr = (int*)take(1024);
  p.bar = (unsigned*)take(XCD_BAR_WORDS * 4);
  p.rowsq = (float*)take((size_t)5 * 50432 * 4);
  char* os = (char*)d_out;
  size_t ooff = 0;
  auto otake = [&](size_t bytes) { char* r = os + ooff; ooff += (bytes + 255) & ~(size_t)255; return r; };
  for (int gi = 0; gi < 2; ++gi) {
    GroupP& g = p.grp[gi];
    g.B = gi == 0 ? 2 : 8;
    int S = gi == 0 ? 8192 : 4096;
    g.L = S + 16;
    g.Lp = (g.L + 127) / 128 * 128;
    g.T = g.B * g.Lp;
    g.Hp = (g.L / 2 + 1 + 127) / 128 * 128;
    g.seq0 = gi == 0 ? 0 : 16640;
    g.x = gi == 0 ? x_prompt : x_sample;
    g.out = (float*)d_out + (gi == 0 ? 0 : (size_t)2 * 8192 * DM);
    size_t T = g.T;
    g.xb = (u16*)otake(T * 2048 * 2);
    g.cq = (u16*)otake(T * 768 * 2);
    g.ckv = (u16*)otake(T * 512 * 2);
    g.kr = (u16*)otake(T * 64 * 2);
    g.kd = (u16*)otake(T * 512 * 2);
    g.uf = (u16*)take(T * 512 * 2);
    g.qd = (u16*)take(T * 512 * 2);
    g.vdt = (u16*)take(T * 512 * 2);
    g.g = (u16*)take(T * 2048 * 2);
    g.q = (u16*)take(T * 1536 * 2);
    g.h1b = (u16*)take(T * 2048 * 2);
    g.abt = (u16*)take((size_t)g.B * 512 * 2 * g.Hp * 2);
    g.fm = (u16*)take((size_t)((g.Hp + 255) / 256 * 256) * 2 * g.Hp * 2);
  }
  const size_t need = off;
  if (need > ws_size || ooff > (size_t)out_size * 4) {
    fprintf(stderr, "workspace too small: need %zu have %zu (out scratch %zu of %zu)\n", need, ws_size, ooff, (size_t)out_size * 4);
    return;
  }

  static int grid_blocks = 0;
  if (!grid_blocks) {
    int dev = 0, cus = 0, per_cu = 0;
    hipGetDevice(&dev);
    hipDeviceGetAttribute(&cus, hipDeviceAttributeMultiprocessorCount, dev);
    hipOccupancyMaxActiveBlocksPerMultiprocessor(&per_cu, mega, NTHR, 0);
    if (per_cu < 1) per_cu = 1;
    if (per_cu > 2) per_cu = 2;
    grid_blocks = cus * per_cu;
  }
  hipMemsetAsync(p.bar, 0, XCD_BAR_WORDS * 4, stream);
#if COOP
  int lo = 0, hi = NPHASE;
  void* args[] = {&p, &lo, &hi};
  hipError_t e = hipLaunchCooperativeKernel((void*)mega, dim3(grid_blocks), dim3(NTHR), args, 0, stream);
  if (e != hipSuccess) fprintf(stderr, "cooperative launch failed: %s (grid %d)\n", hipGetErrorString(e), grid_blocks);
#else
  for (int ph = 0; ph < NPHASE; ++ph) mega<<<grid_blocks, NTHR, 0, stream>>>(p, ph, ph + 1);
#endif
}
```

```cpp
#include <hip/hip_runtime.h>
#include <hip/hip_cooperative_groups.h>
#include <cstdio>
#include <cstring>
#include <cmath>
namespace cg = cooperative_groups;

#ifndef COOP
#define COOP 1
#endif

typedef unsigned short u16;
using bf16x8 = __attribute__((ext_vector_type(8))) short;
using f32x16 = __attribute__((ext_vector_type(16))) float;
using u32x4 = __attribute__((ext_vector_type(4))) unsigned;
using u32x2 = __attribute__((ext_vector_type(2))) unsigned;
#define DI __device__ __forceinline__
#define MFMA(a, b, c) __builtin_amdgcn_mfma_f32_32x32x16_bf16((a), (b), (c), 0, 0, 0)

constexpr int DM = 2048;
constexpr int INW = 5440;
constexpr int INWP = 5504;
constexpr float LOG2E = 1.4426950408889634f;
constexpr int NTHR = 256;
constexpr int SMEM_BYTES = 256 * 144 + 128 * 144 + 1024;

struct GroupP {
  const float* x;
  float* out;
  int B, L, Lp, T;
  int seq0, Hp;
  u16 *xb, *uf, *cq, *ckv, *kr, *qd, *kd, *vdt, *g, *q, *abt, *fm;
  u16* h1b;
};
struct Params {
  GroupP grp[2];
  const float *meta, *rel_bias, *final_norm, *norm_w, *w_in, *w_fmix, *q_norm, *w_uq, *kv_norm, *w_ukv;
  const float *lq1, *lk1, *lq2, *lk2, *diff_norm, *w_o;
  u16 *winT, *wuqT, *wukvT, *woT, *mfT;
  float2* rope;
  float* lam;
  float* hmeta;
  int* ctr;
  unsigned* bar;
  float* rowsq;
  float rope_hi[32], rope_lo[32];
};

DI unsigned pk2(float lo, float hi) {
  typedef __bf16 bf2 __attribute__((ext_vector_type(2)));
  typedef float f2 __attribute__((ext_vector_type(2)));
  f2 v = {lo, hi};
  return __builtin_bit_cast(unsigned, __builtin_convertvector(v, bf2));
}
DI u16 bf1(float x) { return (u16)(pk2(x, 0.f) & 0xffffu); }
DI float bf_lo(unsigned u) { return __uint_as_float(u << 16); }
DI float bf_hi(unsigned u) { return __uint_as_float(u & 0xffff0000u); }
DI int tid_() { int t = threadIdx.x; asm volatile("" : "+v"(t)); return t; }
DI int crow(int i, int h) { return (i & 3) + 8 * (i >> 2) + 4 * h; }
DI float wave_sum(float v) {
#pragma unroll
  for (int o = 32; o >= 1; o >>= 1) v += __shfl_xor(v, o, 64);
  return v;
}

struct ASrc { const u16* p; long ld; };

DI float dot2bf(unsigned a, float c) {
  typedef __bf16 bf2 __attribute__((ext_vector_type(2)));
  bf2 x = __builtin_bit_cast(bf2, a);
  return __builtin_amdgcn_fdot2_f32_bf16(x, x, c, false);
}

template <bool SWAP, bool SSQ, class AF>
DI void gemm_main(AF asrc, int m0, const u16* __restrict__ Bw, int ldb, int K, char* smem,
                  f32x16 (&acc)[4][2], float ssq_eps, float (&rs)[4]) {
  const int tid = tid_(), lane = tid & 63, wid = __builtin_amdgcn_readfirstlane(tid >> 6);
  const int wm = wid >> 1, wn = wid & 1, lr = lane & 31, lh = lane >> 5;
  char* sA = smem;
  char* sB = smem + 256 * 144;
  const int srow = tid >> 3, skc = tid & 7;
  const unsigned lds_st = srow * 144 + skc * 16;
  const unsigned voffB = (unsigned)(srow * ldb * 2 + skc * 16);
  u32x4 ra[8], rb[4];
#pragma unroll
  for (int i = 0; i < 4; ++i) rs[i] = 0.f;
#pragma unroll
  for (int mi = 0; mi < 4; ++mi)
#pragma unroll
    for (int ni = 0; ni < 2; ++ni)
#pragma unroll
      for (int i = 0; i < 16; ++i) acc[mi][ni][i] = 0.f;

  auto gload = [&](int kt) {
    ASrc s = asrc(kt);
    const unsigned voffA = (unsigned)(srow * (int)s.ld * 2 + skc * 16);
    const char* ua = (const char*)s.p + (long)m0 * s.ld * 2;
#pragma unroll
    for (int i = 0; i < 8; ++i) ra[i] = *(const u32x4*)(ua + (long)(32 * i) * s.ld * 2 + voffA);
    const char* ub = (const char*)Bw + (long)kt * 128;
#pragma unroll
    for (int i = 0; i < 4; ++i) rb[i] = *(const u32x4*)(ub + (long)(32 * i) * ldb * 2 + voffB);
  };
  auto sstore = [&]() {
#pragma unroll
    for (int i = 0; i < 8; ++i) *(u32x4*)(sA + lds_st + i * (32 * 144)) = ra[i];
#pragma unroll
    for (int i = 0; i < 4; ++i) *(u32x4*)(sB + lds_st + i * (32 * 144)) = rb[i];
  };

  const int nkt = K >> 6;
  const char* pA = sA + (wm * 128 + lr) * 144 + lh * 16;
  const char* pB = sB + (wn * 64 + lr) * 144 + lh * 16;
  gload(0);
  sstore();
  __syncthreads();
  for (int kt = 0; kt < nkt; ++kt) {
    if (kt + 1 < nkt) gload(kt + 1);
    __builtin_amdgcn_sched_barrier(0);
    {
      bf16x8 ar[3], br[2][2];
      ar[0] = *(const bf16x8*)(pA);
      ar[1] = *(const bf16x8*)(pA + 32 * 144);
      br[0][0] = *(const bf16x8*)(pB);
      br[0][1] = *(const bf16x8*)(pB + 32 * 144);
      __builtin_amdgcn_sched_group_barrier(0x100, 4, 0);
#pragma unroll
      for (int t = 0; t < 16; ++t) {
        const int ks = t >> 2, mi = t & 3;
        if (t + 2 < 16) {
          ar[(t + 2) % 3] = *(const bf16x8*)(pA + ((t + 2) & 3) * (32 * 144) + ((t + 2) >> 2) * 32);
          if (mi == 1 && ks + 1 < 4) {
            br[(ks + 1) & 1][0] = *(const bf16x8*)(pB + (ks + 1) * 32);
            br[(ks + 1) & 1][1] = *(const bf16x8*)(pB + 32 * 144 + (ks + 1) * 32);
            __builtin_amdgcn_sched_group_barrier(0x100, 3, 0);
          } else {
            __builtin_amdgcn_sched_group_barrier(0x100, 1, 0);
          }
        }
        acc[mi][0] = SWAP ? MFMA(br[ks & 1][0], ar[t % 3], acc[mi][0]) : MFMA(ar[t % 3], br[ks & 1][0], acc[mi][0]);
        acc[mi][1] = SWAP ? MFMA(br[ks & 1][1], ar[t % 3], acc[mi][1]) : MFMA(ar[t % 3], br[ks & 1][1], acc[mi][1]);
        __builtin_amdgcn_sched_group_barrier(0x008, 2, 0);
        if (SSQ) {
          u32x4 u = __builtin_bit_cast(u32x4, ar[t % 3]);
#pragma unroll
          for (int j = 0; j < 4; ++j) rs[mi] = dot2bf(u[j], rs[mi]);
        }
      }
    }
    __syncthreads();
    if (kt + 1 < nkt) sstore();
    __syncthreads();
  }
  if (SSQ) {
#pragma unroll
    for (int mi = 0; mi < 4; ++mi) {
      float v = rs[mi] + __shfl_xor(rs[mi], 32, 64);
      rs[mi] = __builtin_amdgcn_rsqf(v / (float)K + ssq_eps);
    }
  }
}

DI int xcd_tile(int it, int total) {
  const int per = (total + 7) >> 3;
  const int j = it >> 3;
  const int t = (it & 7) * per + j;
  return (j < per && t < total) ? t : -1;
}
constexpr int TGM = 4;
DI void tile_mn(int t, int nmt, int nnt, int& mt, int& nt) {
  const int gs = TGM * nnt;
  const int mg = t / gs, r = t - mg * gs;
  const int rem = nmt - mg * TGM;
  const int gsz = rem < TGM ? rem : TGM;
  nt = r / gsz;
  mt = mg * TGM + (r - nt * gsz);
}

DI float silu(float x) { return x * __builtin_amdgcn_rcpf(1.f + __builtin_amdgcn_exp2f(-x * LOG2E)); }

DI void store_bf8_pair(u16* p16, int lh, float a0, float a1, float a2, float a3, float b0, float b1, float b2, float b3) {
  const unsigned pa0 = pk2(a0, a1), pa1 = pk2(a2, a3), pb0 = pk2(b0, b1), pb1 = pk2(b2, b3);
  auto r0 = __builtin_amdgcn_permlane32_swap(pa0, pb0, false, false);
  auto r1 = __builtin_amdgcn_permlane32_swap(pa1, pb1, false, false);
  u32x4 w = {r0[0], r1[0], r0[1], r1[1]};
  *(u32x4*)(p16 + 8 * lh) = w;
}

DI void load_bf8_pair(const u16* p16, int lh, u32x2& ga, u32x2& gb) {
  const u32x4 w = *(const u32x4*)(p16 + 8 * lh);
  auto r0 = __builtin_amdgcn_permlane32_swap(w[0], w[2], false, false);
  auto r1 = __builtin_amdgcn_permlane32_swap(w[1], w[3], false, false);
  ga[0] = r0[0]; ga[1] = r1[0];
  gb[0] = r0[1]; gb[1] = r1[1];
}

DI void store_bf4(u16* dst, float a, float b, float c, float d) {
  u32x2 v;
  v[0] = pk2(a, b);
  v[1] = pk2(c, d);
  *(u32x2*)dst = v;
}

DI void wprep_item(const float* __restrict__ src, u16* __restrict__ dst, int K, int N, const float* __restrict__ rowscale,
                   float cs_val, int cs_lo, int cs_hi, int kt, int nt, char* smem) {
  float* t = (float*)smem;
  const int tid = tid_();
#pragma unroll
  for (int i = 0; i < 16; ++i) {
    int k = i * 4 + (tid >> 6), n = tid & 63;
    int gk = kt * 64 + k, gn = nt * 64 + n;
    float v = 0.f;
    if (gn < N) {
      v = src[(long)gk * N + gn];
      if (rowscale) v *= rowscale[gk];
      if (gn >= cs_lo && gn < cs_hi) v *= cs_val;
    }
    t[k * 65 + n] = v;
  }
  __syncthreads();
#pragma unroll
  for (int i = 0; i < 16; ++i) {
    int n = i * 4 + (tid >> 6), k = tid & 63;
    dst[(long)(nt * 64 + n) * K + kt * 64 + k] = bf1(t[k * 65 + n]);
  }
  __syncthreads();
}

typedef const __attribute__((address_space(4))) float* CF;
DI void phase_wprep(const Params& p, CF rope_hi, CF rope_lo, char* smem, int part) {
  const int tid = tid_();
  const int nWin = 32 * 86, nWuq = 12 * 24, nWukv = 8 * 32, nWo = 32 * 32;
  const int perL = nWin + nWuq + nWukv + nWo;
  for (int it = blockIdx.x; it < 2 * perL; it += gridDim.x) {
    int l = it / perL, r = it % perL;
    if (((l == 0 && r < nWin) ? 0 : 1) != part) continue;
    if (r < nWin) {
      wprep_item(p.w_in + (long)l * DM * INW, p.winT + (long)l * INWP * DM, DM, INW, p.norm_w + l * DM,
                 0.125f * LOG2E, 1856, 2368, r / 86, r % 86, smem);
    } else if ((r -= nWin) < nWuq) {
      wprep_item(p.w_uq + (long)l * 768 * 1536, p.wuqT + (long)l * 1536 * 768, 768, 1536, p.q_norm + l * 768,
                 0.07216878364870322f * LOG2E, 0, 1536, r / 24, r % 24, smem);
    } else if ((r -= nWuq) < nWukv) {
      wprep_item(p.w_ukv + (long)l * 512 * 2048, p.wukvT + (long)l * 2048 * 512, 512, 2048, p.kv_norm + l * 512,
                 1.f, 0, 0, r / 32, r % 32, smem);
    } else {
      r -= nWukv;
      wprep_item(p.w_o + (long)l * DM * DM, p.woT + (long)l * DM * DM, DM, DM, nullptr, 1.f, 0, 0, r / 32, r % 32, smem);
    }
  }
  for (int it = blockIdx.x; it < (part == 1 ? 1024 : 0); it += gridDim.x) {
    int o = it * 256 + tid;
    int c = o & 127, n = (o >> 7) & 255, gg = (o >> 15) & 3, l = o >> 17;
    int d = n & 127, part = n >> 7;
    const float* W = p.w_fmix + (long)(l * 4 + gg) * 128 * 128;
    float s = 0.f;
    for (int cp = 0; cp < 128; ++cp) {
      float fr = (float)((c * cp) & 127) * (1.f / 128.f);
      float tr = part ? __builtin_amdgcn_sinf(fr) : __builtin_amdgcn_cosf(fr);
      s += tr * W[cp * 128 + d];
    }
    p.mfT[o] = bf1(s * 0.08838834764831845f);
  }
  for (int it = blockIdx.x; it < (part == 0 ? (8320 * 32) / 256 : 0); it += gridDim.x) {
    int o = it * 256 + tid;
    int c = o & 31, t = o >> 5;
    float tf = (float)t, hi = rope_hi[c], lo = rope_lo[c];
    float pr = tf * hi;
    float er = fmaf(tf, hi, -pr);
    float fr = (pr - floorf(pr)) + (er + tf * lo);
    p.rope[o] = make_float2(__builtin_amdgcn_cosf(fr), __builtin_amdgcn_sinf(fr));
  }
  if (part == 0 && blockIdx.x == 0 && tid < 128) p.ctr[tid] = 0;
  if (part == 0) {
    for (int i = blockIdx.x * NTHR + tid; i < 5 * 50432; i += gridDim.x * NTHR) p.rowsq[i] = 0.f;
    for (int gi = 0; gi < 2; ++gi) {
      const GroupP& g = p.grp[gi];
      const int npad = g.Lp - g.L;
      const int total = g.B * npad * (DM / 8);
      for (int i = blockIdx.x * NTHR + tid; i < total; i += gridDim.x * NTHR) {
        const int c = i % (DM / 8), rr = i / (DM / 8);
        const int b = rr / npad, t = g.L + (rr - b * npad);
        unsigned zz = 0u; asm volatile("" : "+v"(zz)); u32x4 z = {zz, zz, zz, zz};
        *(u32x4*)(g.h1b + ((long)(b * g.Lp + t)) * DM + c * 8) = z;
      }
    }
  }
  if (part == 1 && blockIdx.x == 0 && tid < 2) {
    int l = tid;
    float a = 0.f, b = 0.f;
    for (int i = 0; i < 64; ++i) {
      a += p.lq1[l * 64 + i] * p.lk1[l * 64 + i];
      b += p.lq2[l * 64 + i] * p.lk2[l * 64 + i];
    }
    float lam_init = l ? 0.35550906759f : 0.2f;
    p.lam[l] = __builtin_amdgcn_exp2f(a * LOG2E) - __builtin_amdgcn_exp2f(b * LOG2E) + lam_init;
  }
}

DI void phase_rowprep(const Params& p, const GroupP& g, int l, int vb) {
  const int tid = tid_(), lane = tid & 63, wid = __builtin_amdgcn_readfirstlane(tid >> 6);
  for (int it = vb; it < g.T / 4; it += gridDim.x) {
    int row = it * 4 + wid;
    int b = row / g.Lp, t = row - b * g.Lp;
    u16* dst = g.xb + (long)row * DM;
    if (t >= g.L) {
      unsigned zz = 0u; asm volatile("" : "+v"(zz)); u32x4 z = {zz, zz, zz, zz};
#pragma unroll
      for (int i = 0; i < 4; ++i) *(u32x4*)(dst + (i * 64 + lane) * 8) = z;
      continue;
    }
    if (l == 0) {
      const float* src = (t < 16) ? p.meta + t * DM : g.x + ((long)b * (g.L - 16) + (t - 16)) * DM;
      float4 v[8];
      float ss = 0.f;
#pragma unroll
      for (int i = 0; i < 8; ++i) {
        v[i] = *(const float4*)(src + (i * 64 + lane) * 4);
        ss += v[i].x * v[i].x + v[i].y * v[i].y + v[i].z * v[i].z + v[i].w * v[i].w;
      }
      ss = wave_sum(ss);
      float r = __builtin_amdgcn_rsqf(ss * (1.f / DM) + 1e-6f);
#pragma unroll
      for (int i = 0; i < 8; ++i) store_bf4(dst + (i * 64 + lane) * 4, v[i].x * r, v[i].y * r, v[i].z * r, v[i].w * r);
    } else {
      const u16* src = g.h1b + (long)row * DM;
      u32x4 v[4];
      float ss = 0.f;
#pragma unroll
      for (int i = 0; i < 4; ++i) {
        v[i] = *(const u32x4*)(src + (i * 64 + lane) * 8);
#pragma unroll
        for (int j = 0; j < 4; ++j) { float a = bf_lo(v[i][j]), c = bf_hi(v[i][j]); ss += a * a + c * c; }
      }
      ss = wave_sum(ss);
      float r = __builtin_amdgcn_rsqf(ss * (1.f / DM) + 1e-6f);
#pragma unroll
      for (int i = 0; i < 4; ++i) {
        u32x4 o;
#pragma unroll
        for (int j = 0; j < 4; ++j) o[j] = pk2(bf_lo(v[i][j]) * r, bf_hi(v[i][j]) * r);
        *(u32x4*)(dst + (i * 64 + lane) * 8) = o;
      }
    }
  }
}

DI void phase_dftfill(const GroupP& g, int vb) {
  const int tid = tid_();
  const int L = g.L, Lp = g.Lp, Hp = g.Hp, H = L >> 1;
  const float invL = 1.f / (float)L, nrm = 1.f / sqrtf((float)L);
  const int nch = (2 * Hp) / 8;
  const int krows = (Hp + 255) / 256 * 256;
  for (int k = vb; k < krows; k += gridDim.x) {
    u16* rowp = g.fm + (long)k * (2 * Hp);
    for (int ch = tid; ch < nch; ch += NTHR) {
      int kk0 = ch * 8;
      int part = kk0 >= Hp;
      int s0 = kk0 - part * Hp;
      float v[8];
      if (k > H) {
#pragma unroll
        for (int j = 0; j < 8; ++j) v[j] = 0.f;
      } else {
        unsigned prod = (unsigned)k * (unsigned)s0;
        int jj = (L == 8208) ? (int)(prod % 8208u) : (int)(prod % 4112u);
#pragma unroll
        for (int j = 0; j < 8; ++j) {
          float fr = (float)jj * invL;
          float tr = part ? -__builtin_amdgcn_sinf(fr) : __builtin_amdgcn_cosf(fr);
          v[j] = (s0 + j <= H) ? tr * nrm : 0.f;
          jj += k;
          if (jj >= L) jj -= L;
        }
      }
      u32x4 o;
      o[0] = pk2(v[0], v[1]); o[1] = pk2(v[2], v[3]); o[2] = pk2(v[4], v[5]); o[3] = pk2(v[6], v[7]);
      *(u32x4*)(rowp + kk0) = o;
    }
  }
}

DI void rope_store(const f32x16& a0, const f32x16& a1, const float2* __restrict__ ropet, u16* dst, int lh) {
#pragma unroll
  for (int pr = 0; pr < 2; ++pr) {
    float o1[2][4], o2[2][4];
#pragma unroll
    for (int e = 0; e < 2; ++e) {
      const int gi = 2 * pr + e;
      const int c0 = 8 * gi + 4 * lh;
      float4 t01 = *(const float4*)(ropet + c0);
      float4 t23 = *(const float4*)(ropet + c0 + 2);
      float cs[4] = {t01.x, t01.z, t23.x, t23.z};
      float sn[4] = {t01.y, t01.w, t23.y, t23.w};
#pragma unroll
      for (int j = 0; j < 4; ++j) {
        float x1 = a0[4 * gi + j], x2 = a1[4 * gi + j];
        o1[e][j] = x1 * cs[j] - x2 * sn[j];
        o2[e][j] = x2 * cs[j] + x1 * sn[j];
      }
    }
    store_bf8_pair(dst + 16 * pr, lh, o1[0][0], o1[0][1], o1[0][2], o1[0][3], o1[1][0], o1[1][1], o1[1][2], o1[1][3]);
    store_bf8_pair(dst + 32 + 16 * pr, lh, o2[0][0], o2[0][1], o2[0][2], o2[0][3], o2[1][0], o2[1][1], o2[1][2], o2[1][3]);
  }
}

DI void phase_inproj(const Params& p, const GroupP& g, int l, char* smem, int vb) {
  const int tid = tid_(), lane = tid & 63, wid = __builtin_amdgcn_readfirstlane(tid >> 6);
  const int wm = wid >> 1, wn = wid & 1, lr = lane & 31, lh = lane >> 5;
  const int nmt = g.T / 256;
  const u16* W = p.winT + (long)l * INWP * DM;
  const int ntiles = nmt * 43;
  for (int it = vb; it < ((ntiles + 7) & ~7); it += gridDim.x) {
    const int tt = xcd_tile(it, ntiles);
    if (tt < 0) continue;
    int nt, mt;
    tile_mn(tt, nmt, 43, mt, nt);
    int m0 = mt * 256, n0 = nt * 128;
    f32x16 acc[4][2];
    const u16* xb = (l == 0) ? g.xb : g.h1b;
    float rsd[4];
    gemm_main<true, false>([&](int kt) { return ASrc{xb + kt * 64, DM}; }, m0, W + (long)n0 * DM, DM, DM, smem, acc, 0.f, rsd);
    const int nw0 = n0 + wn * 64;
    if (nw0 >= INW) continue;
    if (l == 1) {
      const float* sq = p.rowsq + (size_t)4 * 50432 + g.seq0 + m0 + wm * 128 + lr;
#pragma unroll
      for (int mi = 0; mi < 4; ++mi) {
        const float r = __builtin_amdgcn_rsqf(sq[mi * 32] * (1.f / DM) + 1e-6f);
#pragma unroll
        for (int ni = 0; ni < 2; ++ni)
#pragma unroll
          for (int i = 0; i < 16; ++i) acc[mi][ni][i] *= r;
      }
    }
#pragma unroll
    for (int mi = 0; mi < 4; ++mi) {
      int m = m0 + wm * 128 + mi * 32 + lr;
      int b = m / g.Lp, t = m - b * g.Lp;
      if (nw0 == 1792) {
        rope_store(acc[mi][0], acc[mi][1], p.rope + t * 32, g.kr + (long)m * 64, lh);
      } else if (nw0 >= 2880 && nw0 < 3392) {
#pragma unroll
        for (int ni = 0; ni < 2; ++ni)
#pragma unroll
          for (int i = 0; i < 16; ++i) {
            const long uoff = (long)(nw0 - 2880 + ni * 32 + (i & 3) + 8 * (i >> 2)) * g.Lp * 2;
            const unsigned voff = (unsigned)(((b * 512 + 4 * lh) * g.Lp + t) * 2);
            *(u16*)((char*)g.vdt + uoff + voff) = bf1(acc[mi][ni][i]);
          }
      } else {
        u16* dst; int ld, base; bool sil = false;
        if (nw0 < 512) { dst = g.uf; ld = 512; base = 0; }
        else if (nw0 < 1280) { dst = g.cq; ld = 768; base = 512; }
        else if (nw0 < 1792) { dst = g.ckv; ld = 512; base = 1280; }
        else if (nw0 < 2368) { dst = g.qd; ld = 512; base = 1856; }
        else if (nw0 < 2880) { dst = g.kd; ld = 512; base = 2368; }
        else { dst = g.g; ld = 2048; base = 3392; sil = true; }
        if (nw0 >= 512 && nw0 < 1792) {
          float ss = 0.f;
#pragma unroll
          for (int ni = 0; ni < 2; ++ni)
#pragma unroll
            for (int i = 0; i < 16; ++i) ss += acc[mi][ni][i] * acc[mi][ni][i];
          atomicAdd(p.rowsq + (size_t)(l * 2 + (nw0 >= 1280 ? 1 : 0)) * 50432 + g.seq0 + m, ss);
        }
#pragma unroll
        for (int ni = 0; ni < 2; ++ni)
#pragma unroll
          for (int pr = 0; pr < 2; ++pr) {
            int n = nw0 - base + ni * 32 + 16 * pr;
            float v[8];
#pragma unroll
            for (int j = 0; j < 8; ++j) v[j] = acc[mi][ni][8 * pr + j];
            if (sil) {
#pragma unroll
              for (int j = 0; j < 8; ++j) v[j] = silu(v[j]);
            }
            store_bf8_pair(dst + (long)m * ld + n, lh, v[0], v[1], v[2], v[3], v[4], v[5], v[6], v[7]);
          }
      }
    }
  }
}

DI void phase_upproj(const Params& p, const GroupP& g, int l, char* smem, int vb) {
  const int tid = tid_(), lane = tid & 63, wid = __builtin_amdgcn_readfirstlane(tid >> 6);
  const int wm = wid >> 1, wn = wid & 1, lr = lane & 31, lh = lane >> 5;
  const int nmt = g.T / 256;
  u16* kn = g.xb;
  u16* vt = g.xb + (long)g.T * 1024;
  const int ntiles = nmt * 28;
  for (int it = vb; it < ((ntiles + 7) & ~7); it += gridDim.x) {
    const int tt = xcd_tile(it, ntiles);
    if (tt < 0) continue;
    int nt, mt;
    tile_mn(tt, nmt, 28, mt, nt);
    int m0 = mt * 256;
    f32x16 acc[4][2];
    float rs[4];
    if (nt < 28) {
      const bool isq = nt < 12;
      const int n0 = isq ? nt * 128 : (nt - 12) * 128;
      const u16* A = isq ? g.cq : g.ckv;
      const int Kd = isq ? 768 : 512;
      const u16* Bw = isq ? p.wuqT + (long)l * 1536 * 768 + (long)n0 * 768 : p.wukvT + (long)l * 2048 * 512 + (long)n0 * 512;
      gemm_main<true, false>([&](int kt) { return ASrc{A + kt * 64, (long)Kd}; }, m0, Bw, Kd, Kd, smem, acc, 0.f, rs);
      {
        const float* sq = p.rowsq + (size_t)(l * 2 + (isq ? 0 : 1)) * 50432 + g.seq0 + m0 + wm * 128 + lr;
        const float invK = 1.f / (float)Kd;
#pragma unroll
        for (int mi = 0; mi < 4; ++mi) rs[mi] = __builtin_amdgcn_rsqf(sq[mi * 32] * invK + 1e-6f);
      }
      const int nw0 = n0 + wn * 64;
      if (isq) {
        const int head = nw0 / 192, w = nw0 - head * 192;
#pragma unroll
        for (int mi = 0; mi < 4; ++mi) {
          int m = m0 + wm * 128 + mi * 32 + lr;
          float r = rs[mi];
          if (w == 128) {
            int b = m / g.Lp, t = m - b * g.Lp;
            f32x16 a0 = acc[mi][0], a1 = acc[mi][1];
#pragma unroll
            for (int i = 0; i < 16; ++i) { a0[i] *= r; a1[i] *= r; }
            rope_store(a0, a1, p.rope + t * 32, g.q + (long)m * 1536 + nw0, lh);
          } else {
            u16* qp = g.q + (long)m * 1536 + nw0;
#pragma unroll
            for (int ni = 0; ni < 2; ++ni)
#pragma unroll
              for (int pr = 0; pr < 2; ++pr)
                store_bf8_pair(qp + ni * 32 + 16 * pr, lh, acc[mi][ni][8 * pr] * r, acc[mi][ni][8 * pr + 1] * r,
                               acc[mi][ni][8 * pr + 2] * r, acc[mi][ni][8 * pr + 3] * r, acc[mi][ni][8 * pr + 4] * r,
                               acc[mi][ni][8 * pr + 5] * r, acc[mi][ni][8 * pr + 6] * r, acc[mi][ni][8 * pr + 7] * r);
          }
        }
      } else {
        const int head = n0 >> 8, isv = (n0 >> 7) & 1;
        if (!isv) {
#pragma unroll
          for (int mi = 0; mi < 4; ++mi) {
            int m = m0 + wm * 128 + mi * 32 + lr;
            float r = rs[mi];
            u16* kp = kn + (long)m * 1024 + head * 128 + wn * 64;
#pragma unroll
            for (int ni = 0; ni < 2; ++ni)
#pragma unroll
              for (int pr = 0; pr < 2; ++pr)
                store_bf8_pair(kp + ni * 32 + 16 * pr, lh, acc[mi][ni][8 * pr] * r, acc[mi][ni][8 * pr + 1] * r,
                               acc[mi][ni][8 * pr + 2] * r, acc[mi][ni][8 * pr + 3] * r, acc[mi][ni][8 * pr + 4] * r,
                               acc[mi][ni][8 * pr + 5] * r, acc[mi][ni][8 * pr + 6] * r, acc[mi][ni][8 * pr + 7] * r);
          }
        } else {
#pragma unroll
          for (int mi = 0; mi < 4; ++mi) {
            int m = m0 + wm * 128 + mi * 32 + lr;
            float r = rs[mi];
            int b = m / g.Lp, t = m - b * g.Lp;
            const unsigned voff = (unsigned)((((b * 8 + head) * 128 + 4 * lh) * g.Lp + t) * 2);
#pragma unroll
            for (int ni = 0; ni < 2; ++ni)
#pragma unroll
              for (int i = 0; i < 16; ++i) {
                const long uoff = (long)(wn * 64 + ni * 32 + (i & 3) + 8 * (i >> 2)) * g.Lp * 2;
                *(u16*)((char*)vt + uoff + voff) = bf1(acc[mi][ni][i] * r);
              }
          }
        }
      }
    }
  }
  {
    const int Hp = g.Hp, H = g.L >> 1, L = g.L, Lp = g.Lp;
    const int nft = (g.B * Hp) / 256;
    const int srow = tid >> 3, skc = tid & 7;
    char* sA = smem;
    char* sB = smem + 256 * 144;
    for (int it = vb; it < nft * 8; it += gridDim.x) {
      const int nt = it / nft, mt = it - nt * nft;
      const int m0 = mt * 256, n0 = nt * 128;
      const int gg = n0 >> 8, part = (n0 >> 7) & 1;
      const u16* Bw = p.mfT + (long)(l * 4 + gg) * 256 * 128 + (long)(n0 & 255) * 128;
      f32x16 acc[4][2];
#pragma unroll
      for (int mi = 0; mi < 4; ++mi)
#pragma unroll
        for (int ni = 0; ni < 2; ++ni)
#pragma unroll
          for (int i = 0; i < 16; ++i) acc[mi][ni][i] = 0.f;
      for (int kt = 0; kt < 2; ++kt) {
#pragma unroll
        for (int i = 0; i < 8; ++i) {
          const int row = srow + 32 * i;
          const int m = m0 + row;
          const int b = m / Hp, sidx = m - b * Hp;
          const bool pair = sidx >= 1 && sidx < H;
          const bool v1ok = (sidx <= H) && (pair || !part);
          u32x4 v1 = {0u, 0u, 0u, 0u}, v2 = {0u, 0u, 0u, 0u};
          if (v1ok) v1 = *(const u32x4*)(g.uf + ((long)(b * Lp + sidx)) * 512 + gg * 128 + kt * 64 + skc * 8);
          if (pair) v2 = *(const u32x4*)(g.uf + ((long)(b * Lp + L - sidx)) * 512 + gg * 128 + kt * 64 + skc * 8);
          u32x4 o;
#pragma unroll
          for (int j = 0; j < 4; ++j) {
            float a0 = bf_lo(v1[j]), a1 = bf_hi(v1[j]), b0 = bf_lo(v2[j]), b1 = bf_hi(v2[j]);
            o[j] = part ? pk2(a0 - b0, a1 - b1) : pk2(a0 + b0, a1 + b1);
          }
          *(u32x4*)(sA + row * 144 + skc * 16) = o;
        }
#pragma unroll
        for (int i = 0; i < 4; ++i)
          *(u32x4*)(sB + (srow + 32 * i) * 144 + skc * 16) = *(const u32x4*)(Bw + (long)(srow + 32 * i) * 128 + kt * 64 + skc * 8);
        __syncthreads();
#pragma unroll
        for (int ks = 0; ks < 4; ++ks) {
          bf16x8 af[4], bfr[2];
#pragma unroll
          for (int mi = 0; mi < 4; ++mi) af[mi] = *(const bf16x8*)(sA + (wm * 128 + mi * 32 + lr) * 144 + ks * 32 + lh * 16);
#pragma unroll
          for (int ni = 0; ni < 2; ++ni) bfr[ni] = *(const bf16x8*)(sB + (wn * 64 + ni * 32 + lr) * 144 + ks * 32 + lh * 16);
#pragma unroll
          for (int mi = 0; mi < 4; ++mi)
#pragma unroll
            for (int ni = 0; ni < 2; ++ni) acc[mi][ni] = MFMA(af[mi], bfr[ni], acc[mi][ni]);
        }
        __syncthreads();
      }
#pragma unroll
      for (int mi = 0; mi < 4; ++mi)
#pragma unroll
        for (int pr = 0; pr < 2; ++pr) {
          const int m = m0 + wm * 128 + mi * 32 + 16 * pr;
          const int b = m / Hp, sidx = m - b * Hp;
#pragma unroll
          for (int ni = 0; ni < 2; ++ni) {
            const int d = wn * 64 + ni * 32 + lr;
            store_bf8_pair(g.abt + ((long)(b * 512 + gg * 128 + d)) * (2 * Hp) + part * Hp + sidx, lh, acc[mi][ni][8 * pr],
                           acc[mi][ni][8 * pr + 1], acc[mi][ni][8 * pr + 2], acc[mi][ni][8 * pr + 3], acc[mi][ni][8 * pr + 4],
                           acc[mi][ni][8 * pr + 5], acc[mi][ni][8 * pr + 6], acc[mi][ni][8 * pr + 7]);
          }
        }
    }
  }
}

constexpr float SM_THR = 8.f;
DI void softmax_pv(f32x16 (&sa)[2], f32x16 (&O)[4], float& m, float& l, const char* sV, int lr, int lh, bool first) {
  float t0 = fmaxf(fmaxf(sa[0][0], sa[0][1]), sa[0][2]);
  float t1 = fmaxf(fmaxf(sa[1][0], sa[1][1]), sa[1][2]);
#pragma unroll
  for (int i = 3; i < 15; i += 2) {
    t0 = fmaxf(fmaxf(t0, sa[0][i]), sa[0][i + 1]);
    t1 = fmaxf(fmaxf(t1, sa[1][i]), sa[1][i + 1]);
  }
  float tmax = fmaxf(fmaxf(t0, t1), fmaxf(sa[0][15], sa[1][15]));
  tmax = fmaxf(tmax, __shfl_xor(tmax, 32, 64));
  if (first || __any(tmax > SM_THR)) {
    asm volatile("; rescale" ::: "memory");
    const float delta = first ? tmax : fmaxf(tmax, 0.f);
    const float alpha = __builtin_amdgcn_exp2f(-delta);
    m += delta;
    l *= alpha;
#pragma unroll
    for (int d = 0; d < 4; ++d)
#pragma unroll
      for (int i = 0; i < 16; ++i) O[d][i] *= alpha;
#pragma unroll
    for (int i = 0; i < 16; ++i) { sa[0][i] -= delta; sa[1][i] -= delta; }
  }
  float rsum0 = 0.f, rsum1 = 0.f;
#pragma unroll
  for (int i = 0; i < 16; ++i) {
    float p0 = __builtin_amdgcn_exp2f(sa[0][i]);
    float p1 = __builtin_amdgcn_exp2f(sa[1][i]);
    sa[0][i] = p0;
    sa[1][i] = p1;
    rsum0 += p0;
    rsum1 += p1;
  }
  l += rsum0 + rsum1;
  bf16x8 pf[4];
#pragma unroll
  for (int g4 = 0; g4 < 4; ++g4) {
    const int kb = g4 >> 1, s2 = g4 & 1;
    u32x4 pp;
#pragma unroll
    for (int j = 0; j < 4; ++j) pp[j] = pk2(sa[kb][8 * s2 + 2 * j], sa[kb][8 * s2 + 2 * j + 1]);
    pf[g4] = __builtin_bit_cast(bf16x8, pp);
  }
  const char* vrd = sV + lr * 144 + lh * 16;
  bf16x8 vfr[4];
#pragma unroll
  for (int t = 0; t < 3; ++t) vfr[t] = *(const bf16x8*)(vrd + (t & 3) * (32 * 144) + (t >> 2) * 32);
  __builtin_amdgcn_sched_group_barrier(0x100, 3, 0);
#pragma unroll
  for (int t = 0; t < 16; ++t) {
    if (t + 3 < 16) {
      vfr[(t + 3) & 3] = *(const bf16x8*)(vrd + ((t + 3) & 3) * (32 * 144) + ((t + 3) >> 2) * 32);
      __builtin_amdgcn_sched_group_barrier(0x100, 1, 0);
    }
    O[t & 3] = MFMA(vfr[t & 3], pf[t >> 2], O[t & 3]);
    __builtin_amdgcn_sched_group_barrier(0x008, 1, 0);
  }
}

DI void load_vtile(u32x4 (&rv)[4], const u16* __restrict__ vbase, int Lp, int key0, unsigned voffV) {
  const char* ub = (const char*)vbase + (long)key0 * 2;
#pragma unroll
  for (int i = 0; i < 4; ++i) rv[i] = *(const u32x4*)(ub + (long)(32 * i) * Lp * 2 + voffV);
}
DI void store_vtile(const u32x4 (&rv)[4], char* sVst) {
#pragma unroll
  for (int i = 0; i < 4; ++i) {
    u32x2 lo = {rv[i][0], rv[i][1]}, hi = {rv[i][2], rv[i][3]};
    *(u32x2*)(sVst + i * 4608) = lo;
    *(u32x2*)(sVst + i * 4608 + 16) = hi;
  }
}

DI void mla_item(const Params& p, const GroupP& g, int item, char* smem, bool dry) {
  const int tid = tid_(), lane = tid & 63, wid = __builtin_amdgcn_readfirstlane(tid >> 6), lr = lane & 31, lh = lane >> 5;
  const int nqb = g.Lp / 128;
  const int qb = item % nqb, bh = item / nqb, h = bh & 7, b = bh >> 3;
  const int Lp = g.Lp, L = g.L;
  char* sK = smem;
  char* sV = smem + 64 * 400;
  const u16* kn = g.xb + (long)b * Lp * 1024 + h * 128;
  const u16* kr = g.kr + (long)b * Lp * 64;
  const u16* vbase = g.xb + (long)g.T * 1024 + (long)(b * 8 + h) * 128 * Lp;
  const int qrow = b * Lp + qb * 128 + wid * 32 + lr;
  bf16x8 qf[12];
#pragma unroll
  for (int ks = 0; ks < 12; ++ks) qf[ks] = *(const bf16x8*)(g.q + (long)qrow * 1536 + h * 192 + ks * 16 + lh * 8);
  f32x16 O[4];
#pragma unroll
  for (int d = 0; d < 4; ++d)
#pragma unroll
    for (int i = 0; i < 16; ++i) O[d][i] = 0.f;
  float m = 0.f, l = 0.f;
  const int nkt = (L + 63) >> 6;
  u32x4 rk[6], rv[4];
  const unsigned voffKn = (unsigned)((tid >> 4) * 2048 + (tid & 15) * 16);
  const unsigned voffKr = (unsigned)((tid >> 3) * 128 + (tid & 7) * 16);
  const unsigned voffV = (unsigned)(((tid >> 3) * Lp + (tid & 7) * 8) * 2);
  char* sKn_st = sK + (tid >> 4) * 400 + (tid & 15) * 16;
  char* sKr_st = sK + (tid >> 3) * 400 + 256 + (tid & 7) * 16;
  char* sV_st = sV + (tid >> 3) * 144 + ((tid & 7) >> 1) * 32 + (tid & 1) * 8;
  auto loadK = [&](int kt) {
    const char* u1 = (const char*)kn + (long)kt * (64 * 2048);
#pragma unroll
    for (int i = 0; i < 4; ++i) rk[i] = *(const u32x4*)(u1 + i * (16 * 2048) + voffKn);
    const char* u2 = (const char*)kr + (long)kt * (64 * 128);
#pragma unroll
    for (int i = 0; i < 2; ++i) rk[4 + i] = *(const u32x4*)(u2 + i * (32 * 128) + voffKr);
  };
  auto storeK = [&]() {
#pragma unroll
    for (int i = 0; i < 4; ++i) *(u32x4*)(sKn_st + i * 6400) = rk[i];
#pragma unroll
    for (int i = 0; i < 2; ++i) *(u32x4*)(sKr_st + i * 12800) = rk[4 + i];
  };
  loadK(0);
  load_vtile(rv, vbase, Lp, 0, voffV);
  storeK();
  store_vtile(rv, sV_st);
  __syncthreads();
  for (int kt = 0; kt < nkt; ++kt) {
    const bool more = kt + 1 < nkt;
    if (more) loadK(kt + 1);
    __builtin_amdgcn_sched_barrier(0);
    f32x16 sa[2];
#pragma unroll
    for (int i = 0; i < 16; ++i) { sa[0][i] = -m; sa[1][i] = -m; }
    {
      const char* krd = sK + lr * 400 + lh * 16;
      bf16x8 kf[3][2];
#pragma unroll
      for (int q2 = 0; q2 < 2; ++q2) {
        kf[q2][0] = *(const bf16x8*)(krd + q2 * 32);
        kf[q2][1] = *(const bf16x8*)(krd + 32 * 400 + q2 * 32);
      }
      __builtin_amdgcn_sched_group_barrier(0x100, 4, 0);
#pragma unroll
      for (int ks = 0; ks < 12; ++ks) {
        if (ks + 2 < 12) {
          kf[(ks + 2) % 3][0] = *(const bf16x8*)(krd + (ks + 2) * 32);
          kf[(ks + 2) % 3][1] = *(const bf16x8*)(krd + 32 * 400 + (ks + 2) * 32);
          __builtin_amdgcn_sched_group_barrier(0x100, 2, 0);
        }
        sa[0] = MFMA(kf[ks % 3][0], qf[ks], sa[0]);
        sa[1] = MFMA(kf[ks % 3][1], qf[ks], sa[1]);
        __builtin_amdgcn_sched_group_barrier(0x008, 2, 0);
      }
    }
    if (kt == nkt - 1) {
      asm volatile("; masked tail tile" ::: "memory");
#pragma unroll
      for (int kb = 0; kb < 2; ++kb)
#pragma unroll
        for (int i = 0; i < 16; ++i)
          if (kt * 64 + kb * 32 + crow(i, lh) >= L) sa[kb][i] = -1e30f;
    }
    __syncthreads();
    if (more) { storeK(); load_vtile(rv, vbase, Lp, (kt + 1) * 64, voffV); }
    __builtin_amdgcn_sched_barrier(0);
    softmax_pv(sa, O, m, l, sV, lr, lh, kt == 0);
    __syncthreads();
    if (more) store_vtile(rv, sV_st);
  }
  float lt = l + __shfl_xor(l, 32, 64);
  float inv = 1.f / lt;
  const u16* gp = g.g + (long)qrow * 2048 + 512 + h * 128;
  u16* op = (dry ? (u16*)g.out : g.q) + (long)qrow * 1536 + h * 192;
#pragma unroll
  for (int d = 0; d < 4; ++d)
#pragma unroll
    for (int pr = 0; pr < 2; ++pr) {
      const int dd = d * 32 + 16 * pr;
      u32x2 ga, gb;
      load_bf8_pair(gp + dd, lh, ga, gb);
      store_bf8_pair(op + dd, lh, O[d][8 * pr] * inv * bf_lo(ga[0]), O[d][8 * pr + 1] * inv * bf_hi(ga[0]),
                     O[d][8 * pr + 2] * inv * bf_lo(ga[1]), O[d][8 * pr + 3] * inv * bf_hi(ga[1]),
                     O[d][8 * pr + 4] * inv * bf_lo(gb[0]), O[d][8 * pr + 5] * inv * bf_hi(gb[0]),
                     O[d][8 * pr + 6] * inv * bf_lo(gb[1]), O[d][8 * pr + 7] * inv * bf_hi(gb[1]));
    }
  __syncthreads();
}

DI int t5_bucket(int rel) {
  int n = rel < 0 ? -rel : rel;
  int bk;
  if (n < 8) bk = n;
  else if (n < 12) bk = 8;
  else if (n < 16) bk = 9;
  else if (n < 23) bk = 10;
  else if (n < 32) bk = 11;
  else if (n < 46) bk = 12;
  else if (n < 64) bk = 13;
  else if (n < 91) bk = 14;
  else bk = 15;
  return bk + (rel > 0 ? 16 : 0);
}

DI void diff_item(const Params& p, const GroupP& g, int l_layer, int item, char* smem, bool dry) {
  const int tid = tid_(), lane = tid & 63, wid = __builtin_amdgcn_readfirstlane(tid >> 6), lr = lane & 31, lh = lane >> 5;
  const int nqb = (g.L + 63) / 64;
  const int qb = item % nqb, bh = item / nqb, h = bh & 3, b = bh >> 2;
  const int Lp = g.Lp, L = g.L;
  const int map = wid >> 1, qs = wid & 1;
  char* sK = smem;
  char* sV = smem + 64 * 272;
  float* sBias = (float*)(smem + 64 * 272 + 128 * 144);
  float* o2buf = (float*)smem;
  const u16* kd = g.kd + (long)b * Lp * 512 + h * 128;
  const u16* vbase = g.vdt + (long)(b * 4 + h) * 128 * Lp;
  const int qpos = qb * 64 + qs * 32 + lr;
  const long qrow = (long)b * Lp + qpos;
  for (int i = tid; i < 257; i += NTHR) sBias[i] = p.rel_bias[t5_bucket(i - 128) * 4 + h] * LOG2E;
  const float bneg = p.rel_bias[15 * 4 + h] * LOG2E, bpos = p.rel_bias[31 * 4 + h] * LOG2E;
  bf16x8 qf[4];
#pragma unroll
  for (int ks = 0; ks < 4; ++ks) qf[ks] = *(const bf16x8*)(g.qd + qrow * 512 + h * 128 + map * 64 + ks * 16 + lh * 8);
  f32x16 O[4];
#pragma unroll
  for (int d = 0; d < 4; ++d)
#pragma unroll
    for (int i = 0; i < 16; ++i) O[d][i] = 0.f;
  float m = 0.f, l = 0.f;
  const int nkt = (L + 63) >> 6;
  u32x4 rk[4], rv[4];
  const unsigned voffK = (unsigned)((tid >> 4) * 1024 + (tid & 15) * 16);
  const unsigned voffV = (unsigned)(((tid >> 3) * Lp + (tid & 7) * 8) * 2);
  char* sK_st = sK + (tid >> 4) * 272 + (tid & 15) * 16;
  char* sV_st = sV + (tid >> 3) * 144 + ((tid & 7) >> 1) * 32 + (tid & 1) * 8;
  auto loadK = [&](int kt) {
    const char* u1 = (const char*)kd + (long)kt * (64 * 1024);
#pragma unroll
    for (int i = 0; i < 4; ++i) rk[i] = *(const u32x4*)(u1 + i * (16 * 1024) + voffK);
  };
  auto storeK = [&]() {
#pragma unroll
    for (int i = 0; i < 4; ++i) *(u32x4*)(sK_st + i * (16 * 272)) = rk[i];
  };
  const int qw0 = qb * 64 + qs * 32;
  loadK(0);
  load_vtile(rv, vbase, Lp, 0, voffV);
  storeK();
  store_vtile(rv, sV_st);
  __syncthreads();
  for (int kt = 0; kt < nkt; ++kt) {
    const bool more = kt + 1 < nkt;
    if (more) loadK(kt + 1);
    __builtin_amdgcn_sched_barrier(0);
    const int key0 = kt * 64;
    const int relmin = key0 - (qw0 + 31), relmax = key0 + 63 - qw0;
    const bool farp = relmin >= 128, farn = relmax <= -128;
    const float binit = (farp ? bpos : (farn ? bneg : 0.f)) - m;
    f32x16 sa[2];
#pragma unroll
    for (int i = 0; i < 16; ++i) { sa[0][i] = binit; sa[1][i] = binit; }
    {
      const char* krd = sK + lr * 272 + map * 128 + lh * 16;
      bf16x8 kf[4][2];
#pragma unroll
      for (int ks = 0; ks < 4; ++ks) {
        kf[ks][0] = *(const bf16x8*)(krd + ks * 32);
        kf[ks][1] = *(const bf16x8*)(krd + 32 * 272 + ks * 32);
      }
#pragma unroll
      for (int ks = 0; ks < 4; ++ks) {
        sa[0] = MFMA(kf[ks][0], qf[ks], sa[0]);
        sa[1] = MFMA(kf[ks][1], qf[ks], sa[1]);
      }
    }
    if (!farp && !farn) {
      asm volatile("; near-diagonal bias tile" ::: "memory");
#pragma unroll
      for (int kb = 0; kb < 2; ++kb)
#pragma unroll
        for (int i = 0; i < 16; ++i) {
          int rel = key0 + kb * 32 + crow(i, lh) - qpos;
          rel = rel < -128 ? -128 : (rel > 128 ? 128 : rel);
          sa[kb][i] += sBias[rel + 128];
        }
    }
    if (kt == nkt - 1) {
      asm volatile("; masked tail tile" ::: "memory");
#pragma unroll
      for (int kb = 0; kb < 2; ++kb)
#pragma unroll
        for (int i = 0; i < 16; ++i)
          if (key0 + kb * 32 + crow(i, lh) >= L) sa[kb][i] = -1e30f;
    }
    __syncthreads();
    if (more) { storeK(); load_vtile(rv, vbase, Lp, (kt + 1) * 64, voffV); }
    __builtin_amdgcn_sched_barrier(0);
    softmax_pv(sa, O, m, l, sV, lr, lh, kt == 0);
    __syncthreads();
    if (more) store_vtile(rv, sV_st);
  }
  float lt = l + __shfl_xor(l, 32, 64);
  float inv = 1.f / lt;
  if (map == 1) {
#pragma unroll
    for (int d = 0; d < 4; ++d)
#pragma unroll
      for (int i = 0; i < 16; ++i) o2buf[(d * 32 + crow(i, lh)) * 64 + qs * 32 + lr] = O[d][i] * inv;
  }
  __syncthreads();
  if (map == 0) {
    const float lam = p.lam[l_layer];
    const float lam_init = l_layer ? 0.35550906759f : 0.2f;
    float ss = 0.f;
#pragma unroll
    for (int d = 0; d < 4; ++d)
#pragma unroll
      for (int i = 0; i < 16; ++i) {
        float o = O[d][i] * inv - lam * o2buf[(d * 32 + crow(i, lh)) * 64 + qs * 32 + lr];
        O[d][i] = o;
        ss += o * o;
      }
    ss += __shfl_xor(ss, 32, 64);
    float r = __builtin_amdgcn_rsqf(ss * (1.f / 128.f) + 1e-5f) * (1.f - lam_init);
    const u16* gp = g.g + qrow * 2048 + 1536 + h * 128;
    const float* dn = p.diff_norm + l_layer * 128;
    u16* op = (dry ? (u16*)g.out + (long)g.T * 1536 : g.qd) + qrow * 512 + h * 128;
#pragma unroll
    for (int d = 0; d < 4; ++d)
#pragma unroll
      for (int pr = 0; pr < 2; ++pr) {
        const int dd = d * 32 + 16 * pr;
        u32x2 ga, gb;
        load_bf8_pair(gp + dd, lh, ga, gb);
        const float4 wa = *(const float4*)(dn + dd + 4 * lh);
        const float4 wb = *(const float4*)(dn + dd + 8 + 4 * lh);
        store_bf8_pair(op + dd, lh, O[d][8 * pr] * r * wa.x * bf_lo(ga[0]), O[d][8 * pr + 1] * r * wa.y * bf_hi(ga[0]),
                       O[d][8 * pr + 2] * r * wa.z * bf_lo(ga[1]), O[d][8 * pr + 3] * r * wa.w * bf_hi(ga[1]),
                       O[d][8 * pr + 4] * r * wb.x * bf_lo(gb[0]), O[d][8 * pr + 5] * r * wb.y * bf_hi(gb[0]),
                       O[d][8 * pr + 6] * r * wb.z * bf_lo(gb[1]), O[d][8 * pr + 7] * r * wb.w * bf_hi(gb[1]));
      }
  }
  __syncthreads();
}

DI float* dft_part(const GroupP& g, int part) { return (float*)g.cq + (size_t)part * g.B * g.Hp * 512; }
DI void dft_item(const Params& p, const GroupP& g, int item, char* smem) {
  const int tid = tid_(), lane = tid & 63, wid = __builtin_amdgcn_readfirstlane(tid >> 6);
  const int wm = wid >> 1, wn = wid & 1, lr = lane & 31, lh = lane >> 5;
  const int nb8 = g.B * 8;
  int mt = item / nb8, r = item - mt * nb8;
  int b = r >> 3, nt = (r >> 1) & 3, part = r & 1;
  int m0 = mt * 256, n0 = nt * 128;
  const int Hp = g.Hp, K2 = 2 * Hp;
  f32x16 acc[4][2];
  const u16* A = g.fm + part * Hp;
  float rsd[4];
  gemm_main<true, false>([&](int kt) { return ASrc{A + kt * 64, (long)K2}; }, m0, g.abt + ((long)b * 512 + n0) * K2 + part * Hp, K2, Hp, smem, acc, 0.f, rsd);
  float* dst = dft_part(g, part) + (size_t)b * Hp * 512;
#pragma unroll
  for (int mi = 0; mi < 4; ++mi) {
    int mm = m0 + wm * 128 + mi * 32 + lr;
    if (mm >= Hp) continue;
#pragma unroll
    for (int ni = 0; ni < 2; ++ni)
#pragma unroll
      for (int gi = 0; gi < 4; ++gi) {
        int n = n0 + wn * 64 + ni * 32 + 8 * gi + 4 * lh;
        float4 o = {acc[mi][ni][4 * gi], acc[mi][ni][4 * gi + 1], acc[mi][ni][4 * gi + 2], acc[mi][ni][4 * gi + 3]};
        *(float4*)(dst + (size_t)mm * 512 + n) = o;
      }
  }
}

DI void phase_dftfin(const GroupP& g, int vb) {
  const int tid = tid_();
  const int H = g.L >> 1, Hp = g.Hp, L = g.L, Lp = g.Lp;
  const float* P = dft_part(g, 0);
  const float* Q = dft_part(g, 1);
  const int total = g.B * (H + 1) * 128;
  for (int i = vb * NTHR + tid; i < total; i += gridDim.x * NTHR) {
    const int c = i & 127, rk = i >> 7;
    const int b = rk / (H + 1), k = rk - b * (H + 1);
    const size_t src = ((size_t)b * Hp + k) * 512 + c * 4;
    const float4 pv = *(const float4*)(P + src);
    const float4 qv = *(const float4*)(Q + src);
    const long row1 = (long)b * Lp + k;
    const u32x2 g1 = *(const u32x2*)(g.g + row1 * 2048 + c * 4);
    store_bf4(g.uf + row1 * 512 + c * 4, (pv.x + qv.x) * bf_lo(g1[0]), (pv.y + qv.y) * bf_hi(g1[0]), (pv.z + qv.z) * bf_lo(g1[1]),
              (pv.w + qv.w) * bf_hi(g1[1]));
    if (k >= 1 && k < H) {
      const long row2 = (long)b * Lp + (L - k);
      const u32x2 g2 = *(const u32x2*)(g.g + row2 * 2048 + c * 4);
      store_bf4(g.uf + row2 * 512 + c * 4, (pv.x - qv.x) * bf_lo(g2[0]), (pv.y - qv.y) * bf_hi(g2[0]), (pv.z - qv.z) * bf_lo(g2[1]),
                (pv.w - qv.w) * bf_hi(g2[1]));
    }
  }
}

DI int pad8(int n) { return (n + 7) & ~7; }

DI void phase_mix(const Params& p, int l, char* smem, int xcc) {
  const GroupP& ga = p.grp[0];
  const GroupP& gb = p.grp[1];
  int* s_item = (int*)(smem + SMEM_BYTES - 16);
  const int G = gridDim.x;
  {
    const int nDft1 = gb.B * ((gb.Hp + 255) / 256) * 8;
    const int nDft0 = ga.B * ((ga.Hp + 255) / 256) * 8;
    for (int it = blockIdx.x; it < pad8(nDft1); it += G) {
      const int tt = xcd_tile(it, nDft1);
      if (tt >= 0) dft_item(p, gb, tt, smem);
    }
    const int vb = (blockIdx.x + G - pad8(nDft1) % G) % G;
    for (int it = vb; it < pad8(nDft0); it += G) {
      const int tt = xcd_tile(it, nDft0);
      if (tt >= 0) dft_item(p, ga, tt, smem);
    }
  }
  const int nqbMa = ga.Lp / 128, nqbDa = (ga.L + 63) / 64, nqbMb = gb.Lp / 128, nqbDb = (gb.L + 63) / 64;
  const int nMa = ga.B * nqbMa, nDa = (ga.B >> 1) * nqbDa;
  const int nMb = gb.B * nqbMb, nDb = (gb.B >> 1) * nqbDb;
  const int e0 = nMa, e1 = e0 + nDa, e2 = e1 + nMb, perX = e2 + nDb;
  int* ctrb = p.ctr + l * 8;
  for (int steal = 0; steal < 8; ++steal) {
    const int q = (xcc + steal) & 7;
    for (;;) {
      if (threadIdx.x == 0) *s_item = atomicAdd(&ctrb[q], 1);
      __syncthreads();
      const int j = *s_item;
      __syncthreads();
      if (j >= perX) break;
      if (j < e0) {
        const int pl = j / nqbMa, qb = j - pl * nqbMa;
        mla_item(p, ga, (q + 8 * pl) * nqbMa + qb, smem, false);
      } else if (j < e1) {
        const int jj = j - e0;
        const int pl = jj / nqbDa, qb = jj - pl * nqbDa;
        diff_item(p, ga, l, (q + 8 * pl) * nqbDa + qb, smem, false);
      } else if (j < e2) {
        const int jj = j - e1;
        const int pl = jj / nqbMb, qb = jj - pl * nqbMb;
        mla_item(p, gb, (q + 8 * pl) * nqbMb + qb, smem, false);
      } else {
        const int jj = j - e2;
        const int pl = jj / nqbDb, qb = jj - pl * nqbDb;
        diff_item(p, gb, l, (q + 8 * pl) * nqbDb + qb, smem, false);
      }
    }
  }
}

DI void phase_outproj(const Params& p, const GroupP& g, int l, char* smem, int vb) {
  const int tid = tid_(), lane = tid & 63, wid = __builtin_amdgcn_readfirstlane(tid >> 6);
  const int wm = wid >> 1, wn = wid & 1, lr = lane & 31, lh = lane >> 5;
  const int nmt = g.T / 256;
  const u16* W = p.woT + (long)l * DM * DM;
  const int ntiles = nmt * 16;
  for (int it = vb; it < ((ntiles + 7) & ~7); it += gridDim.x) {
    const int tt = xcd_tile(it, ntiles);
    if (tt < 0) continue;
    int nt, mt;
    tile_mn(tt, nmt, 16, mt, nt);
    int m0 = mt * 256, n0 = nt * 128;
    f32x16 acc[4][2];
    const u16 *uf = g.uf, *q = g.q, *qd = g.qd;
    float rsd[4];
    gemm_main<true, false>(
        [&](int kt) {
          int k0 = kt * 64;
          if (k0 < 512) return ASrc{uf + k0, 512};
          if (k0 < 1536) { int kk = k0 - 512; return ASrc{q + (kk >> 7) * 192 + (kk & 127), 1536}; }
          return ASrc{qd + (k0 - 1536), 512};
        },
        m0, W + (long)n0 * DM, DM, DM, smem, acc, 0.f, rsd);
#pragma unroll
    for (int mi = 0; mi < 4; ++mi) {
      int m = m0 + wm * 128 + mi * 32 + lr;
      int b = m / g.Lp, t = m - b * g.Lp;
      if (t >= g.L) continue;
      if (l == 0) {
        const float* res = (t < 16) ? p.meta + t * DM : g.x + ((long)b * (g.L - 16) + (t - 16)) * DM;
        u16* dst = g.h1b + (long)m * DM;
        float ss = 0.f;
#pragma unroll
        for (int ni = 0; ni < 2; ++ni)
#pragma unroll
          for (int pr = 0; pr < 2; ++pr) {
            const int n = n0 + wn * 64 + ni * 32 + 16 * pr;
            const float4 ra = *(const float4*)(res + n + 4 * lh);
            const float4 rb = *(const float4*)(res + n + 8 + 4 * lh);
            const float a0 = ra.x + acc[mi][ni][8 * pr], a1 = ra.y + acc[mi][ni][8 * pr + 1];
            const float a2 = ra.z + acc[mi][ni][8 * pr + 2], a3 = ra.w + acc[mi][ni][8 * pr + 3];
            const float b0 = rb.x + acc[mi][ni][8 * pr + 4], b1 = rb.y + acc[mi][ni][8 * pr + 5];
            const float b2 = rb.z + acc[mi][ni][8 * pr + 6], b3 = rb.w + acc[mi][ni][8 * pr + 7];
            store_bf8_pair(dst + n, lh, a0, a1, a2, a3, b0, b1, b2, b3);
            ss += a0 * a0 + a1 * a1 + a2 * a2 + a3 * a3 + b0 * b0 + b1 * b1 + b2 * b2 + b3 * b3;
          }
        atomicAdd(p.rowsq + (size_t)4 * 50432 + g.seq0 + m, ss);
      } else {
        if (t < 16) continue;
        const u16* res = g.h1b + (long)m * DM;
        float* dst = g.out + ((long)b * (g.L - 16) + (t - 16)) * DM;
#pragma unroll
        for (int ni = 0; ni < 2; ++ni)
#pragma unroll
          for (int pr = 0; pr < 2; ++pr) {
            const int n = n0 + wn * 64 + ni * 32 + 16 * pr;
            u32x2 ra, rb;
            load_bf8_pair(res + n, lh, ra, rb);
            float4 oa = {bf_lo(ra[0]) + acc[mi][ni][8 * pr], bf_hi(ra[0]) + acc[mi][ni][8 * pr + 1],
                         bf_lo(ra[1]) + acc[mi][ni][8 * pr + 2], bf_hi(ra[1]) + acc[mi][ni][8 * pr + 3]};
            float4 ob = {bf_lo(rb[0]) + acc[mi][ni][8 * pr + 4], bf_hi(rb[0]) + acc[mi][ni][8 * pr + 5],
                         bf_lo(rb[1]) + acc[mi][ni][8 * pr + 6], bf_hi(rb[1]) + acc[mi][ni][8 * pr + 7]};
            *(float4*)(dst + n + 4 * lh) = oa;
            *(float4*)(dst + n + 8 + 4 * lh) = ob;
          }
      }
    }
  }
}

DI void phase_final(const Params& p) {
  const int tid = tid_(), lane = tid & 63, wid = __builtin_amdgcn_readfirstlane(tid >> 6);
  const int rows0 = p.grp[0].B * (p.grp[0].L - 16), rows1 = p.grp[1].B * (p.grp[1].L - 16);
  for (int it = blockIdx.x; it < (rows0 + rows1) / 4; it += gridDim.x) {
    int row = it * 4 + wid;
    float* ptr = (row < rows0) ? p.grp[0].out + (long)row * DM : p.grp[1].out + (long)(row - rows0) * DM;
    float4 v[8];
    float ss = 0.f;
#pragma unroll
    for (int i = 0; i < 8; ++i) {
      v[i] = *(const float4*)(ptr + (i * 64 + lane) * 4);
      ss += v[i].x * v[i].x + v[i].y * v[i].y + v[i].z * v[i].z + v[i].w * v[i].w;
    }
    ss = wave_sum(ss);
    float r = __builtin_amdgcn_rsqf(ss * (1.f / DM) + 1e-6f);
#pragma unroll
    for (int i = 0; i < 8; ++i) {
      float4 w = *(const float4*)(p.final_norm + (i * 64 + lane) * 4);
      float4 o = {v[i].x * r * w.x, v[i].y * r * w.y, v[i].z * r * w.z, v[i].w * r * w.w};
      *(float4*)(ptr + (i * 64 + lane) * 4) = o;
    }
  }
}

#define XB_TMO      128
#define XB_XCNT(j)  (256  + 64 * (j))
#define XB_XSUB(j)  (1280 + 64 * (j))
#define XB_XGEN(j)  (2304 + 64 * (j))
#define XB_TOP      3328
#define XB_TOPGEN   3392
#define XCD_BAR_WORDS 3456
#define XB_SPIN_CAP (1u << 22)
#define LAS __attribute__((address_space(3)))
DI unsigned xb_ld(unsigned* p) { return __hip_atomic_load(p, __ATOMIC_RELAXED, __HIP_MEMORY_SCOPE_AGENT); }
DI unsigned xb_add(unsigned* p, unsigned v) { return __hip_atomic_fetch_add(p, v, __ATOMIC_RELAXED, __HIP_MEMORY_SCOPE_AGENT); }
DI unsigned xb_xcc_id() { return (unsigned)__builtin_amdgcn_s_getreg((3 << 11) | 20) & 0xFu; }
#define XB_SPIN(cond, bar) do { unsigned _sp = 0; while (cond) { __builtin_amdgcn_s_sleep(1); \
    if ((++_sp & 255u) == 0u) { if (xb_ld(&(bar)[XB_TMO])) break; if (_sp > XB_SPIN_CAP) { atomicAdd(&(bar)[XB_TMO], 1u); break; } } } } while (0)
struct XcdBarrier { unsigned* bar; unsigned x; volatile LAS unsigned* st; };
DI XcdBarrier xcd_barrier_post(unsigned* bar, volatile LAS unsigned* st) {
  XcdBarrier b; b.bar = bar; b.x = xb_xcc_id(); b.st = st;
  if (threadIdx.x == 0) (void)xb_add(&bar[XB_XCNT(b.x)], 1u);
  return b;
}
DI void xcd_barrier_complete(unsigned* bar, unsigned x, unsigned& nloc, unsigned& nx) {
  const unsigned G = gridDim.x * gridDim.y * gridDim.z;
  unsigned sum, cnt, mine, sp = 0u;
  for (;;) {
    sum = 0u; cnt = 0u; mine = 0u;
#pragma unroll
    for (unsigned j = 0; j < 16; ++j) { const unsigned c = xb_ld(&bar[XB_XCNT(j)]); sum += c; cnt += (c > 0u) ? 1u : 0u; mine = (j == x) ? c : mine; }
    if (sum == G) break;
    __builtin_amdgcn_s_sleep(1);
    if ((++sp & 255u) == 0u) { if (xb_ld(&bar[XB_TMO])) break; if (sp > XB_SPIN_CAP) { atomicAdd(&bar[XB_TMO], 1u); break; } }
  }
  nloc = mine > 0u ? mine : 1u; nx = cnt > 0u ? cnt : 1u;
}
DI void xcd_barrier(const XcdBarrier& b) {
  asm volatile("s_waitcnt vmcnt(0)" ::: "memory");
  __syncthreads();
  if (threadIdx.x == 0) {
    unsigned* bar = b.bar;
    __builtin_amdgcn_s_waitcnt(0);
    unsigned nloc = b.st[0], nx = b.st[1];
    if (nloc == 0u) { xcd_barrier_complete(bar, b.x, nloc, nx); b.st[0] = nloc; b.st[1] = nx; }
    const unsigned old = xb_add(&bar[XB_XSUB(b.x)], 1u);
    const unsigned gen = old / nloc;
    if (old + 1u == (gen + 1u) * nloc) {
      __builtin_amdgcn_fence(__ATOMIC_RELEASE, "agent");
      asm volatile("s_waitcnt vmcnt(0)" ::: "memory");
      const unsigned og = xb_add(&bar[XB_TOP], 1u);
      const unsigned tg = og / nx;
      if (og + 1u == (tg + 1u) * nx) xb_add(&bar[XB_TOPGEN], 1u);
      else XB_SPIN(xb_ld(&bar[XB_TOPGEN]) == tg, bar);
      __builtin_amdgcn_fence(__ATOMIC_ACQUIRE, "agent");
      xb_add(&bar[XB_XGEN(b.x)], 1u);
      asm volatile("s_waitcnt vmcnt(0)" ::: "memory");
    } else {
      XB_SPIN(xb_ld(&bar[XB_XGEN(b.x)]) == gen, bar);
      __builtin_amdgcn_fence(__ATOMIC_ACQUIRE, "agent");
      asm volatile("s_waitcnt vmcnt(0)" ::: "memory");
    }
  }
  __syncthreads();
}

constexpr int NPHASE = 12;

__global__ void __launch_bounds__(NTHR, 2) mega(Params p_unused, int ph_lo, int ph_hi) {
  __shared__ __attribute__((aligned(16))) char smem[SMEM_BYTES];
  __shared__ uint4 xb_words;
  if (threadIdx.x == 0) xb_words = make_uint4(0u, 0u, 0u, 0u);
  __syncthreads();
  {
    typedef const __attribute__((address_space(4))) Params* CPP0;
    CPP0 kp0 = (CPP0)__builtin_amdgcn_kernarg_segment_ptr();
    (void)xcd_barrier_post(kp0->bar, (volatile LAS unsigned*)&xb_words);
  }
  for (int ph = ph_lo; ph < ph_hi; ++ph) {
    typedef const __attribute__((address_space(4))) char* CP;
    CP kq = (CP)__builtin_amdgcn_kernarg_segment_ptr();
    asm volatile("" : "+s"(kq));
    typedef const __attribute__((address_space(4))) Params* CPP;
    CPP kp = (CPP)kq;
    Params p;
    p.grp[0].x = kp->grp[0].x;
    p.grp[0].out = kp->grp[0].out;
    p.grp[0].B = kp->grp[0].B;
    p.grp[0].L = kp->grp[0].L;
    p.grp[0].Lp = kp->grp[0].Lp;
    p.grp[0].T = kp->grp[0].T;
    p.grp[0].seq0 = kp->grp[0].seq0;
    p.grp[0].Hp = kp->grp[0].Hp;
    p.grp[0].xb = kp->grp[0].xb;
    p.grp[0].uf = kp->grp[0].uf;
    p.grp[0].cq = kp->grp[0].cq;
    p.grp[0].ckv = kp->grp[0].ckv;
    p.grp[0].kr = kp->grp[0].kr;
    p.grp[0].qd = kp->grp[0].qd;
    p.grp[0].kd = kp->grp[0].kd;
    p.grp[0].vdt = kp->grp[0].vdt;
    p.grp[0].g = kp->grp[0].g;
    p.grp[0].q = kp->grp[0].q;
    p.grp[0].abt = kp->grp[0].abt;
    p.grp[0].fm = kp->grp[0].fm;
    p.grp[0].h1b = kp->grp[0].h1b;
    p.grp[1].x = kp->grp[1].x;
    p.grp[1].out = kp->grp[1].out;
    p.grp[1].B = kp->grp[1].B;
    p.grp[1].L = kp->grp[1].L;
    p.grp[1].Lp = kp->grp[1].Lp;
    p.grp[1].T = kp->grp[1].T;
    p.grp[1].seq0 = kp->grp[1].seq0;
    p.grp[1].Hp = kp->grp[1].Hp;
    p.grp[1].xb = kp->grp[1].xb;
    p.grp[1].uf = kp->grp[1].uf;
    p.grp[1].cq = kp->grp[1].cq;
    p.grp[1].ckv = kp->grp[1].ckv;
    p.grp[1].kr = kp->grp[1].kr;
    p.grp[1].qd = kp->grp[1].qd;
    p.grp[1].kd = kp->grp[1].kd;
    p.grp[1].vdt = kp->grp[1].vdt;
    p.grp[1].g = kp->grp[1].g;
    p.grp[1].q = kp->grp[1].q;
    p.grp[1].abt = kp->grp[1].abt;
    p.grp[1].fm = kp->grp[1].fm;
    p.grp[1].h1b = kp->grp[1].h1b;
    p.meta = kp->meta;
    p.rel_bias = kp->rel_bias;
    p.final_norm = kp->final_norm;
    p.norm_w = kp->norm_w;
    p.w_in = kp->w_in;
    p.w_fmix = kp->w_fmix;
    p.q_norm = kp->q_norm;
    p.w_uq = kp->w_uq;
    p.kv_norm = kp->kv_norm;
    p.w_ukv = kp->w_ukv;
    p.lq1 = kp->lq1;
    p.lk1 = kp->lk1;
    p.lq2 = kp->lq2;
    p.lk2 = kp->lk2;
    p.diff_norm = kp->diff_norm;
    p.w_o = kp->w_o;
    p.winT = kp->winT;
    p.wuqT = kp->wuqT;
    p.wukvT = kp->wukvT;
    p.woT = kp->woT;
    p.mfT = kp->mfT;
    p.rope = kp->rope;
    p.lam = kp->lam;
    p.hmeta = kp->hmeta;
    p.ctr = kp->ctr;
    p.bar = kp->bar;
    p.rowsq = kp->rowsq;
    if (ph == 11) {
      phase_final(p);
    } else {
      const int l = ph >= 6 ? 1 : 0, st = ph >= 6 ? ph - 5 : ph;
      const GroupP& g0 = p.grp[0];
      const GroupP& g1 = p.grp[1];
      const int G = gridDim.x, bid = blockIdx.x;
      if (st == 0) {
        if (ph == 0) phase_wprep(p, &kp->rope_hi[0], &kp->rope_lo[0], smem, 0);
        phase_rowprep(p, g1, l, bid);
        phase_rowprep(p, g0, l, (bid + G - (g1.T / 4) % G) % G);
      } else if (st == 1) {
        phase_inproj(p, g1, l, smem, bid);
        phase_inproj(p, g0, l, smem, (bid + G - pad8((g1.T / 256) * 43) % G) % G);
        if (l == 0) {
          phase_wprep(p, &kp->rope_hi[0], &kp->rope_lo[0], smem, 1);
          phase_dftfill(g1, G - 1 - bid);
          phase_dftfill(g0, G - 1 - bid);
        }
      } else if (st == 2) {
        phase_upproj(p, g1, l, smem, bid);
        phase_upproj(p, g0, l, smem, (bid + G - pad8((g1.T / 256) * 28) % G) % G);
      } else if (st == 3) {
        phase_mix(p, l, smem, (int)(xb_xcc_id() & 7u));
      } else if (st == 4) {
        phase_dftfin(g1, bid);
        phase_dftfin(g0, bid);
      } else {
        phase_outproj(p, g1, l, smem, bid);
        phase_outproj(p, g0, l, smem, (bid + G - pad8((g1.T / 256) * 16) % G) % G);
      }
    }
    if (ph + 1 < ph_hi) {
      XcdBarrier xb;
      xb.bar = p.bar; xb.x = xb_xcc_id(); xb.st = (volatile LAS unsigned*)&xb_words;
      xcd_barrier(xb);
    }
    if (ph_hi == 0x7fffffff) cg::this_grid().sync();
  }
}

extern "C" void kernel_launch(void* const* d_in, const int* in_sizes, int n_in, void* d_out, int out_size, void* d_ws,
                              size_t ws_size, hipStream_t stream) {
  Params p;
  memset(&p, 0, sizeof(p));
  const float* x_prompt = (const float*)d_in[0];
  const float* x_sample = (const float*)d_in[1];
  p.meta = (const float*)d_in[2];
  p.rel_bias = (const float*)d_in[3];
  p.final_norm = (const float*)d_in[4];
  p.norm_w = (const float*)d_in[5];
  p.w_in = (const float*)d_in[6];
  p.w_fmix = (const float*)d_in[7];
  p.q_norm = (const float*)d_in[8];
  p.w_uq = (const float*)d_in[9];
  p.kv_norm = (const float*)d_in[10];
  p.w_ukv = (const float*)d_in[11];
  p.lq1 = (const float*)d_in[12];
  p.lk1 = (const float*)d_in[13];
  p.lq2 = (const float*)d_in[14];
  p.lk2 = (const float*)d_in[15];
  p.diff_norm = (const float*)d_in[16];
  p.w_o = (const float*)d_in[17];

  for (int c = 0; c < 32; ++c) {
    double inv = pow(10000.0, -(double)c / 32.0) / (2.0 * 3.14159265358979323846);
    float hi = (float)inv;
    p.rope_hi[c] = hi;
    p.rope_lo[c] = (float)(inv - (double)hi);
  }
  char* ws = (char*)d_ws;
  size_t off = 0;
  auto take = [&](size_t bytes) { char* r = ws + off; off += (bytes + 255) & ~(size_t)255; return r; };
  p.winT = (u16*)take((size_t)2 * INWP * DM * 2);
  p.wuqT = (u16*)take((size_t)2 * 1536 * 768 * 2);
  p.wukvT = (u16*)take((size_t)2 * 2048 * 512 * 2);
  p.woT = (u16*)take((size_t)2 * DM * DM * 2);
  p.mfT = (u16*)take((size_t)2 * 4 * 256 * 128 * 2);
  p.rope = (float2*)take((size_t)8320 * 32 * 8);
  p.lam = (float*)take(256);
  p.hmeta = (float*)take((size_t)10 * 16 * DM * 4);
  p.ctr = (int*)take(1024);
  p.bar = (unsigned*)take(XCD_BAR_WORDS * 4);
  p.rowsq = (float*)take((size_t)5 * 50432 * 4);
  char* os = (char*)d_out;
  size_t ooff = 0;
  auto otake = [&](size_t bytes) { char* r = os + ooff; ooff += (bytes + 255) & ~(size_t)255; return r; };
  for (int gi = 0; gi < 2; ++gi) {
    GroupP& g = p.grp[gi];
    g.B = gi == 0 ? 2 : 8;
    int S = gi == 0 ? 8192 : 4096;
    g.L = S + 16;
    g.Lp = (g.L + 127) / 128 * 128;
    g.T = g.B * g.Lp;
    g.Hp = (g.L / 2 + 1 + 127) / 128 * 128;
    g.seq0 = gi == 0 ? 0 : 16640;
    g.x = gi == 0 ? x_prompt : x_sample;
    g.out = (float*)d_out + (gi == 0 ? 0 : (size_t)2 * 8192 * DM);
    size_t T = g.T;
    g.xb = (u16*)otake(T * 2048 * 2);
    g.cq = (u16*)otake(T * 768 * 2);
    g.ckv = (u16*)otake(T * 512 * 2);
    g.kr = (u16*)otake(T * 64 * 2);
    g.kd = (u16*)otake(T * 512 * 2);
    g.uf = (u16*)take(T * 512 * 2);
    g.qd = (u16*)take(T * 512 * 2);
    g.vdt = (u16*)take(T * 512 * 2);
    g.g = (u16*)take(T * 2048 * 2);
    g.q = (u16*)take(T * 1536 * 2);
    g.h1b = (u16*)take(T * 2048 * 2);
    g.abt = (u16*)take((size_t)g.B * 512 * 2 * g.Hp * 2);
    g.fm = (u16*)take((size_t)((g.Hp + 255) / 256 * 256) * 2 * g.Hp * 2);
  }
  const size_t need = off;
  if (need > ws_size || ooff > (size_t)out_size * 4) {
    fprintf(stderr, "workspace too small: need %zu have %zu (out scratch %zu of %zu)\n", need, ws_size, ooff, (size_t)out_size * 4);
    return;
  }

  static int grid_blocks = 0;
  if (!grid_blocks) {
    int dev = 0, cus = 0, per_cu = 0;
    hipGetDevice(&dev);
    hipDeviceGetAttribute(&cus, hipDeviceAttributeMultiprocessorCount, dev);
    hipOccupancyMaxActiveBlocksPerMultiprocessor(&per_cu, mega, NTHR, 0);
    if (per_cu < 1) per_cu = 1;
    if (per_cu > 2) per_cu = 2;
    grid_blocks = cus * per_cu;
  }
  hipMemsetAsync(p.bar, 0, XCD_BAR_WORDS * 4, stream);
#if COOP
  int lo = 0, hi = NPHASE;
  void* args[] = {&p, &lo, &hi};
  hipError_t e = hipLaunchCooperativeKernel((void*)mega, dim3(grid_blocks), dim3(NTHR), args, 0, stream);
  if (e != hipSuccess) fprintf(stderr, "cooperative launch failed: %s (grid %d)\n", hipGetErrorString(e), grid_blocks);
#else
  for (int ph = 0; ph < NPHASE; ++ph) mega<<<grid_blocks, NTHR, 0, stream>>>(p, ph, ph + 1);
#endif
}
```
